# Optimizing an MI355X kernel written in HIP

```python
import math
import jax, jax.numpy as jnp
from jax import lax
import numpy as np

D_MODEL = 1024
BATCH = 8
SEQ = 8192
DEPTH = 2
DEC_BATCH = 4
DEC_SEQ = 4096
PAST_LEN = 128

EPS = 1e-6
ROPE_THETA = 10000.0
N_BRANCH = 3
CHUNK = 128
A_GROUPS = 8
A_WIDTH = 1024
A_GD = A_WIDTH // A_GROUPS
B_HEADS = 8
B_Q_RANK = 384
B_KV_RANK = 256
B_NOPE = 128
B_ROPE = 64
B_VDIM = 128
B_WIDTH = B_HEADS * B_VDIM
Q_BLOCK = 128
C_HEADS = 8
C_KV_HEADS = 2
C_HD = 128
C_WIDTH = C_HEADS * C_HD
C_KV_WIDTH = C_KV_HEADS * C_HD
WINDOW = 128
C_BLOCK = 128
D_FF = -(-8 * D_MODEL // (3 * 256)) * 256
IN_SIZES = (A_WIDTH, A_WIDTH, B_Q_RANK, B_KV_RANK, B_ROPE, C_WIDTH, C_KV_WIDTH, C_KV_WIDTH, N_BRANCH * D_MODEL)
IN_COLS = A_WIDTH * 2 + B_Q_RANK + B_KV_RANK + B_ROPE + C_WIDTH + 2 * C_KV_WIDTH + N_BRANCH * D_MODEL

kernel_name = "hybrid_gated_gmlp_mla_swa_encoder"


def rmsnorm(x, g):
    xf = x.astype(jnp.float32)
    y = xf * lax.rsqrt(jnp.mean(xf * xf, axis=-1, keepdims=True) + EPS)
    return (y * g.astype(jnp.float32)).astype(x.dtype)


def layernorm(x, g, b):
    xf = x.astype(jnp.float32)
    mu = jnp.mean(xf, axis=-1, keepdims=True)
    xc = xf - mu
    var = jnp.mean(xc * xc, axis=-1, keepdims=True)
    y = xc * lax.rsqrt(var + EPS) * g.astype(jnp.float32) + b.astype(jnp.float32)
    return y.astype(x.dtype)


def rope_tables(seq, dim):
    inv = 1.0 / (ROPE_THETA ** (jnp.arange(0, dim, 2, dtype=jnp.float32) / dim))
    ang = jnp.arange(seq, dtype=jnp.float32)[:, None] * inv[None, :]
    return jnp.cos(ang), jnp.sin(ang)


def apply_rope(x, cos, sin):
    xf = x.astype(jnp.float32)
    half = x.shape[-1] // 2
    x1, x2 = xf[..., :half], xf[..., half:]
    c = cos[None, :, None, :]
    s = sin[None, :, None, :]
    return jnp.concatenate([x1 * c - x2 * s, x2 * c + x1 * s], axis=-1).astype(x.dtype)


def spatial_gating(u, v, ln_g, ln_b, w_s, b_s):
    bsz, seq, _ = v.shape
    u = jax.nn.gelu(u)
    v = layernorm(jax.nn.gelu(v), ln_g, ln_b)
    vc = v.reshape(bsz, seq // CHUNK, CHUNK, A_GROUPS, A_GD)
    mixed = jnp.einsum('gij,bcjgd->bcigd', w_s, vc) + b_s.T[None, None, :, :, None]
    return u * mixed.reshape(bsz, seq, A_WIDTH)


def mla(c_q, c_kv, k_rope_in, q_norm_g, w_uq, kv_norm_g, w_ukv, cos, sin):
    bsz, seq, _ = c_q.shape
    q = (rmsnorm(c_q, q_norm_g) @ w_uq).reshape(bsz, seq, B_HEADS, B_NOPE + B_ROPE)
    q_nope = q[..., :B_NOPE]
    q_pe = apply_rope(q[..., B_NOPE:], cos, sin)
    kv = (rmsnorm(c_kv, kv_norm_g) @ w_ukv).reshape(bsz, seq, B_HEADS, B_NOPE + B_VDIM)
    k_nope = kv[..., :B_NOPE]
    v = kv[..., B_NOPE:]
    k_pe = apply_rope(k_rope_in[:, :, None, :], cos, sin)[:, :, 0, :]
    scale = (B_NOPE + B_ROPE) ** -0.5
    nqb = seq // Q_BLOCK
    qn_blk = q_nope.reshape(bsz, nqb, Q_BLOCK, B_HEADS, B_NOPE).transpose(1, 0, 2, 3, 4)
    qp_blk = q_pe.reshape(bsz, nqb, Q_BLOCK, B_HEADS, B_ROPE).transpose(1, 0, 2, 3, 4)

    def attend(blk):
        qn, qp = blk
        s = (jnp.einsum('bqhd,bkhd->bhqk', qn, k_nope) + jnp.einsum('bqhr,bkr->bhqk', qp, k_pe)).astype(jnp.float32) * scale
        p = jax.nn.softmax(s, axis=-1).astype(v.dtype)
        return jnp.einsum('bhqk,bkhd->bqhd', p, v)

    o = lax.map(attend, (qn_blk, qp_blk))
    return o.transpose(1, 0, 2, 3, 4).reshape(bsz, seq, B_WIDTH)


def window_gqa(q, k, v, sink, cos, sin):
    bsz, seq, _ = q.shape
    rep = C_HEADS // C_KV_HEADS
    nb = seq // C_BLOCK
    q = apply_rope(q.reshape(bsz, seq, C_HEADS, C_HD), cos, sin)
    k = apply_rope(k.reshape(bsz, seq, C_KV_HEADS, C_HD), cos, sin)
    v = v.reshape(bsz, seq, C_KV_HEADS, C_HD)
    qb = q.reshape(bsz, nb, C_BLOCK, C_KV_HEADS, rep, C_HD)
    pad = ((0, 0), (C_BLOCK, C_BLOCK), (0, 0), (0, 0))
    kp = jnp.pad(k, pad).reshape(bsz, nb + 2, C_BLOCK, C_KV_HEADS, C_HD)
    vp = jnp.pad(v, pad).reshape(bsz, nb + 2, C_BLOCK, C_KV_HEADS, C_HD)
    kb = jnp.concatenate([kp[:, :-2], kp[:, 1:-1], kp[:, 2:]], axis=2)
    vb = jnp.concatenate([vp[:, :-2], vp[:, 1:-1], vp[:, 2:]], axis=2)
    s = jnp.einsum('bnqgrd,bnkgd->bngrqk', qb, kb).astype(jnp.float32) * (C_HD ** -0.5)
    qi = jnp.arange(C_BLOCK)[:, None]
    kj = jnp.arange(3 * C_BLOCK)[None, :] - C_BLOCK
    kabs = (jnp.arange(nb) * C_BLOCK)[:, None, None] + kj[None]
    valid = (jnp.abs(kj - qi) <= WINDOW)[None] & (kabs >= 0) & (kabs < seq)
    s = jnp.where(valid[None, :, None, None, :, :], s, -jnp.inf)
    sink_b = sink.astype(jnp.float32).reshape(1, 1, C_KV_HEADS, rep, 1, 1)
    m = jnp.maximum(jnp.max(s, axis=-1, keepdims=True), sink_b)
    e = jnp.exp(s - m)
    p = e / (jnp.sum(e, axis=-1, keepdims=True) + jnp.exp(sink_b - m))
    o = jnp.einsum('bngrqk,bnkgd->bnqgrd', p.astype(v.dtype), vb)
    return o.reshape(bsz, seq, C_WIDTH)


def encoder_layer(x, pre_mix_g, w_in, a_ln_g, a_ln_b, a_w_s, a_b_s, b_q_norm_g, b_w_uq, b_kv_norm_g, b_w_ukv,
                  c_sink, w_pa, w_pb, w_pc, w_o, post_mix_g, pre_ffn_g, w_gate, w_up, w_down, post_ffn_g,
                  rope_b, rope_c):
    bsz, seq, _ = x.shape
    h = rmsnorm(x, pre_mix_g)
    proj = h @ w_in
    idx = np.cumsum(IN_SIZES)[:-1].tolist()
    u, v, c_q, c_kv, k_r, cq, ck, cv, gates = jnp.split(proj, idx, axis=-1)
    y_a = spatial_gating(u, v, a_ln_g, a_ln_b, a_w_s, a_b_s)
    y_b = mla(c_q, c_kv, k_r, b_q_norm_g, b_w_uq, b_kv_norm_g, b_w_ukv, rope_b[0], rope_b[1])
    y_c = window_gqa(cq, ck, cv, c_sink, rope_c[0], rope_c[1])
    g = jax.nn.sigmoid(gates.astype(jnp.float32)).astype(x.dtype).reshape(bsz, seq, N_BRANCH, D_MODEL)
    merged = g[:, :, 0] * (y_a @ w_pa) + g[:, :, 1] * (y_b @ w_pb) + g[:, :, 2] * (y_c @ w_pc)
    x = x + rmsnorm(merged @ w_o, post_mix_g)
    h = rmsnorm(x, pre_ffn_g)
    f = (jax.nn.silu(h @ w_gate) * (h @ w_up)) @ w_down
    return x + rmsnorm(f, post_ffn_g)


def trunk(x, pre_mix_g, w_in, a_ln_g, a_ln_b, a_w_s, a_b_s, b_q_norm_g, b_w_uq, b_kv_norm_g, b_w_ukv,
          c_sink, w_pa, w_pb, w_pc, w_o, post_mix_g, pre_ffn_g, w_gate, w_up, w_down, post_ffn_g):
    seq = x.shape[1]
    rope_b = rope_tables(seq, B_ROPE)
    rope_c = rope_tables(seq, C_HD)
    for l in range(DEPTH):
        x = encoder_layer(x, pre_mix_g[l], w_in[l], a_ln_g[l], a_ln_b[l], a_w_s[l], a_b_s[l],
                          b_q_norm_g[l], b_w_uq[l], b_kv_norm_g[l], b_w_ukv[l], c_sink[l],
                          w_pa[l], w_pb[l], w_pc[l], w_o[l], post_mix_g[l], pre_ffn_g[l],
                          w_gate[l], w_up[l], w_down[l], post_ffn_g[l], rope_b, rope_c)
    return x


def setup_inputs(seed: int = 0) -> dict:
    key = jax.random.key(seed)
    ks = jax.random.split(key, 24)

    def nrm(k, shape, scale):
        return jax.random.normal(k, shape, jnp.float32) * scale

    def gain(k, n):
        return 1.0 + nrm(k, (DEPTH, n), 0.02)

    return {
        "x_prompt": nrm(ks[0], (BATCH, SEQ, D_MODEL), 1.0),
        "x_sample": nrm(ks[1], (DEC_BATCH, DEC_SEQ, D_MODEL), 1.0),
        "pre_mix_g": gain(ks[2], D_MODEL),
        "w_in": nrm(ks[3], (DEPTH, D_MODEL, IN_COLS), D_MODEL ** -0.5),
        "a_ln_g": gain(ks[4], A_WIDTH),
        "a_ln_b": nrm(ks[5], (DEPTH, A_WIDTH), 0.02),
        "a_w_s": nrm(ks[6], (DEPTH, A_GROUPS, CHUNK, CHUNK), CHUNK ** -0.5),
        "a_b_s": 1.0 + nrm(ks[7], (DEPTH, A_GROUPS, CHUNK), 0.02),
        "b_q_norm_g": gain(ks[8], B_Q_RANK),
        "b_w_uq": nrm(ks[9], (DEPTH, B_Q_RANK, B_HEADS * (B_NOPE + B_ROPE)), B_Q_RANK ** -0.5),
        "b_kv_norm_g": gain(ks[10], B_KV_RANK),
        "b_w_ukv": nrm(ks[11], (DEPTH, B_KV_RANK, B_HEADS * (B_NOPE + B_VDIM)), B_KV_RANK ** -0.5),
        "c_sink": nrm(ks[12], (DEPTH, C_HEADS), 0.5),
        "w_pa": nrm(ks[13], (DEPTH, A_WIDTH, D_MODEL), A_WIDTH ** -0.5),
        "w_pb": nrm(ks[14], (DEPTH, B_WIDTH, D_MODEL), B_WIDTH ** -0.5),
        "w_pc": nrm(ks[15], (DEPTH, C_WIDTH, D_MODEL), C_WIDTH ** -0.5),
        "w_o": nrm(ks[16], (DEPTH, D_MODEL, D_MODEL), D_MODEL ** -0.5),
        "post_mix_g": gain(ks[17], D_MODEL),
        "pre_ffn_g": gain(ks[18], D_MODEL),
        "w_gate": nrm(ks[19], (DEPTH, D_MODEL, D_FF), D_MODEL ** -0.5),
        "w_up": nrm(ks[20], (DEPTH, D_MODEL, D_FF), D_MODEL ** -0.5),
        "w_down": nrm(ks[21], (DEPTH, D_FF, D_MODEL), D_FF ** -0.5),
        "post_ffn_g": gain(ks[22], D_MODEL),
    }


def reference(x_prompt, x_sample, pre_mix_g, w_in, a_ln_g, a_ln_b, a_w_s, a_b_s, b_q_norm_g, b_w_uq,
              b_kv_norm_g, b_w_ukv, c_sink, w_pa, w_pb, w_pc, w_o, post_mix_g, pre_ffn_g, w_gate, w_up,
              w_down, post_ffn_g):
    y_prompt = trunk(x_prompt, pre_mix_g, w_in, a_ln_g, a_ln_b, a_w_s, a_b_s, b_q_norm_g, b_w_uq,
                     b_kv_norm_g, b_w_ukv, c_sink, w_pa, w_pb, w_pc, w_o, post_mix_g, pre_ffn_g,
                     w_gate, w_up, w_down, post_ffn_g)
    y_sample = trunk(x_sample, pre_mix_g, w_in, a_ln_g, a_ln_b, a_w_s, a_b_s, b_q_norm_g, b_w_uq,
                     b_kv_norm_g, b_w_ukv, c_sink, w_pa, w_pb, w_pc, w_o, post_mix_g, pre_ffn_g,
                     w_gate, w_up, w_down, post_ffn_g)
    return (y_prompt, y_sample)
```

```cpp
#include <hip/hip_runtime.h>
#include <hip/hip_cooperative_groups.h>
#include <cstdio>
#include <cmath>
#include <cstdint>
#include <cstring>
namespace cg = cooperative_groups;

#define DEV __device__ __forceinline__
typedef unsigned short bf16_t;
typedef short bf16x8 __attribute__((ext_vector_type(8)));
typedef short s16x4 __attribute__((ext_vector_type(4)));
typedef float f32x16 __attribute__((ext_vector_type(16)));
typedef float f32x4 __attribute__((ext_vector_type(4)));
typedef unsigned u32x4 __attribute__((ext_vector_type(4)));
typedef unsigned u32x2 __attribute__((ext_vector_type(2)));

constexpr int DM = 1024, INP = 7424, DFF = 2816, TG = 32768, NTHR = 512;
constexpr int C_U = 0, C_V = 1024, C_CQL = 2048, C_CKV = 2432, C_KR = 2688, C_Q = 2752, C_K = 3776, C_VV = 4032, C_G = 4288, C_END = 7360;
constexpr float EPS = 1e-6f;
constexpr size_t SZ_WIN = (size_t)INP * 1024 * 2, SZ_WUQ = (size_t)1536 * 384 * 2, SZ_WUKV = (size_t)2048 * 256 * 2, SZ_SQ = (size_t)1024 * 1024 * 2,
                 SZ_WGU = (size_t)5632 * 1024 * 2, SZ_WD = (size_t)1024 * DFF * 2, SZ_WS = (size_t)8 * 128 * 128 * 2;
constexpr size_t O_WIN = 0, O_WUQ = O_WIN + SZ_WIN, O_WUKV = O_WUQ + SZ_WUQ, O_WPA = O_WUKV + SZ_WUKV, O_WPB = O_WPA + SZ_SQ, O_WPC = O_WPB + SZ_SQ,
                 O_WO = O_WPC + SZ_SQ, O_WGU = O_WO + SZ_SQ, O_WD = O_WGU + SZ_WGU, O_WS = O_WD + SZ_WD, WL = O_WS + SZ_WS;
constexpr size_t O_R128 = 2 * WL, O_R64 = O_R128 + (size_t)8192 * 64 * 8, O_BAR = O_R64 + (size_t)8192 * 32 * 8, O_RS1 = O_BAR + 16384,
                  O_RS2 = O_RS1 + (size_t)TG * 4, O_ACT = O_RS2 + (size_t)TG * 4;
constexpr size_t O_HN = O_ACT, O_PROJ = O_HN + (size_t)TG * 1024 * 2, O_QM = O_PROJ + (size_t)TG * INP * 2, O_KM = O_QM + (size_t)TG * 1536 * 2,
                 O_VM = O_KM + (size_t)TG * 1536 * 2, O_YB = O_VM + (size_t)TG * 1024 * 2, WS_END = O_YB + (size_t)TG * 1024 * 2;
constexpr size_t O_MERGED = O_HN, O_MIX = O_QM, O_H2 = O_VM, O_TT = O_PROJ, O_FF = O_QM;
constexpr int LDS_BYTES = 151552 + 64;
#ifndef PH_MASK
#define PH_MASK 0xFFFF
#endif
#define PH(k) constexpr ((PH_MASK >> (k)) & 1)

struct Params {
  const float* in[23];
  float* out;
  char* ws;
};
__constant__ double RPP128[64] = {0.15915494309189535, 0.13782250260398285, 0.11934937021124886, 0.10335229661843406, 0.08949940160889101, 0.07750328875537404, 0.06711508300522726, 0.05811926744187624, 0.050329212104487035, 0.04358330210530733, 0.03774158471741978, 0.032682865872357, 0.028302195830623395, 0.024508691862069852, 0.02122365276477766, 0.018378926105679667, 0.015915494309189534, 0.013782250260398287, 0.011934937021124886, 0.010335229661843406, 0.0089499401608891, 0.0077503288755374055, 0.006711508300522725, 0.005811926744187624, 0.005032921210448704, 0.004358330210530732, 0.0037741584717419768, 0.0032682865872357, 0.00283021958306234, 0.002450869186206985, 0.0021223652764777662, 0.0018378926105679669, 0.0015915494309189536, 0.0013782250260398283, 0.0011934937021124887, 0.0010335229661843407, 0.0008949940160889102, 0.0007750328875537407, 0.0006711508300522726, 0.0005811926744187624, 0.0005032921210448703, 0.0004358330210530733, 0.0003774158471741977, 0.0003268286587235699, 0.000283021958306234, 0.0002450869186206985, 0.0002122365276477766, 0.00018378926105679666, 0.00015915494309189535, 0.00013782250260398286, 0.00011934937021124885, 0.00010335229661843405, 8.949940160889102e-05, 7.750328875537406e-05, 6.711508300522727e-05, 5.811926744187624e-05, 5.0329212104487035e-05, 4.358330210530733e-05, 3.774158471741978e-05, 3.2682865872357e-05, 2.8302195830623396e-05, 2.4508691862069852e-05, 2.122365276477766e-05, 1.8378926105679668e-05};
__constant__ double RPP64[32] = {0.15915494309189535, 0.11934937021124886, 0.08949940160889101, 0.06711508300522726, 0.050329212104487035, 0.03774158471741978, 0.028302195830623395, 0.02122365276477766, 0.015915494309189534, 0.011934937021124886, 0.0089499401608891, 0.006711508300522725, 0.005032921210448704, 0.0037741584717419768, 0.00283021958306234, 0.0021223652764777662, 0.0015915494309189536, 0.0011934937021124887, 0.0008949940160889102, 0.0006711508300522726, 0.0005032921210448703, 0.0003774158471741977, 0.000283021958306234, 0.0002122365276477766, 0.00015915494309189535, 0.00011934937021124885, 8.949940160889102e-05, 6.711508300522727e-05, 5.0329212104487035e-05, 3.774158471741978e-05, 2.8302195830623396e-05, 2.122365276477766e-05};
DEV int ltid() { int t = threadIdx.x; asm volatile("" : "+v"(t)); return t; }

typedef __bf16 bf16x2_t __attribute__((ext_vector_type(2)));
typedef float f32x2 __attribute__((ext_vector_type(2)));
DEV unsigned cvtpk(float lo, float hi) { f32x2 v = {lo, hi}; bf16x2_t b = __builtin_convertvector(v, bf16x2_t); return __builtin_bit_cast(unsigned, b); }
DEV bf16_t f2bf(float x) { return (bf16_t)(cvtpk(x, 0.f) & 0xffffu); }
DEV float bf2f(bf16_t u) { return __uint_as_float(((unsigned)u) << 16); }
DEV float bflo(unsigned w) { return __uint_as_float(w << 16); }
DEV float bfhi(unsigned w) { return __uint_as_float(w & 0xffff0000u); }
DEV int crow(int r, int hi) { return (r & 3) + 8 * (r >> 2) + 4 * hi; }
DEV float gelu_t(float x) { float z = 0.7978845608f * (x + 0.044715f * x * x * x); return x * __builtin_amdgcn_rcpf(1.f + __expf(-2.f * z)); }
DEV float sigm(float x) { return __builtin_amdgcn_rcpf(1.f + __expf(-x)); }
#define SBAR() __builtin_amdgcn_sched_barrier(0)

constexpr int G_ROWB = 144;
template <int MI> struct GemmCfg { static constexpr int TM = 128 * MI, AB = TM * G_ROWB, BB = 256 * G_ROWB, STAGE = AB + BB, RS_OFF = 2 * STAGE; };

template <int MI, bool ROWSS>
DEV void gemm_mainloop(f32x16 (&acc)[MI][4], float (&ss)[MI], const bf16_t* __restrict__ A, int lda, const bf16_t* __restrict__ Bt, int ldb, int K, char* lds) {
  using C = GemmCfg<MI>;
  const int tid = ltid(), lane = tid & 63, wid = tid >> 6, r32 = lane & 31, hi = lane >> 5, wm = wid & 3, wn = wid >> 2;
  u32x4 ra[2 * MI], rb[4];
  const int prow = tid >> 3, pkc = (tid & 7) * 8;
  const bf16_t* ga = A + (size_t)prow * lda + pkc;
  const bf16_t* gb = Bt + (size_t)prow * ldb + pkc;
  const int lw = prow * G_ROWB + pkc * 2;
  const int aoff = (wm * 32 * MI + r32) * G_ROWB + hi * 16;
  const int boff = C::AB + (wn * 128 + r32) * G_ROWB + hi * 16;
#pragma unroll
  for (int mi = 0; mi < MI; ++mi) {
    ss[mi] = 0.f;
#pragma unroll
    for (int nf = 0; nf < 4; ++nf)
#pragma unroll
      for (int r = 0; r < 16; ++r) acc[mi][nf][r] = 0.f;
  }
  const int nk = K >> 6;
#define G_LOAD(kt_) do { const int k0_ = (kt_) << 6; \
    _Pragma("unroll") for (int i = 0; i < 2 * MI; ++i) ra[i] = *(const u32x4*)(ga + (size_t)i * 64 * lda + k0_); \
    _Pragma("unroll") for (int i = 0; i < 4; ++i) rb[i] = *(const u32x4*)(gb + (size_t)i * 64 * ldb + k0_); } while (0)
#define G_WRITE(s_) do { char* wb_ = lds + (s_) * C::STAGE; \
    _Pragma("unroll") for (int i = 0; i < 2 * MI; ++i) *(u32x4*)(wb_ + lw + i * 64 * G_ROWB) = ra[i]; \
    _Pragma("unroll") for (int i = 0; i < 4; ++i) *(u32x4*)(wb_ + C::AB + lw + i * 64 * G_ROWB) = rb[i]; } while (0)
  G_LOAD(0); G_WRITE(0); G_LOAD(1);
  __syncthreads();
  for (int kt = 0; kt < nk; ++kt) {
    const char* base = lds + (kt & 1) * C::STAGE;
    SBAR();
#pragma unroll
    for (int ks = 0; ks < 4; ++ks) {
      bf16x8 a[MI], b[4];
#pragma unroll
      for (int mi = 0; mi < MI; ++mi) a[mi] = *(const bf16x8*)(base + aoff + mi * 32 * G_ROWB + ks * 32);
#pragma unroll
      for (int nf = 0; nf < 4; ++nf) b[nf] = *(const bf16x8*)(base + boff + nf * 32 * G_ROWB + ks * 32);
      if (ROWSS) {
#pragma unroll
        for (int mi = 0; mi < MI; ++mi)
#pragma unroll
          for (int j = 0; j < 8; ++j) { float f = bf2f((bf16_t)a[mi][j]); ss[mi] += f * f; }
      }
      __builtin_amdgcn_s_setprio(1);
#pragma unroll
      for (int mi = 0; mi < MI; ++mi)
#pragma unroll
        for (int nf = 0; nf < 4; ++nf) acc[mi][nf] = __builtin_amdgcn_mfma_f32_32x32x16_bf16(a[mi], b[nf], acc[mi][nf], 0, 0, 0);
      __builtin_amdgcn_s_setprio(0);
    }
    SBAR();
    if (kt + 1 < nk) { G_WRITE((kt + 1) & 1); if (kt + 2 < nk) G_LOAD(kt + 2); }
    __syncthreads();
  }
#undef G_LOAD
#undef G_WRITE
}

template <int MI>
DEV void rowss_finish(float (&ss)[MI], int K, char* lds) {
  using C = GemmCfg<MI>;
  const int tid = ltid(), lane = tid & 63, wid = tid >> 6, r32 = lane & 31, hi = lane >> 5, wm = wid & 3, wn = wid >> 2;
  float* rs_l = (float*)(lds + C::RS_OFF);
#pragma unroll
  for (int mi = 0; mi < MI; ++mi) {
    float t = ss[mi] + __shfl_xor(ss[mi], 32);
    if (wn == 0 && hi == 0) rs_l[wm * 32 * MI + mi * 32 + r32] = rsqrtf(t / (float)K + EPS);
  }
  __syncthreads();
}

DEV int v_st(int k, int c) { const int kk = (k & ~0xC) | ((k & 4) << 1) | ((k & 8) >> 1); return ((kk >> 3) * 4 + (c >> 5)) * 512 + ((kk & 7) * 32 + (c & 31)) * 2; }
DEV int v_rd_base(int lane) { return ((lane & 3) << 3) | (((lane >> 2) & 3) << 6) | (((lane >> 4) & 1) << 5) | (((lane >> 5) & 1) << 8); }
constexpr int v_rd_off(int d0, int ks, int half) { return d0 * 512 + ks * 4096 + half * 2048; }
template <int OFF> DEV s16x4 tr_read(int vb) { s16x4 r; asm volatile("ds_read_b64_tr_b16 %0, %1 offset:%2" : "=&v"(r) : "v"(vb), "i"(OFF) : "memory"); return r; }
template <int D0, bool SPLIT = true> DEV void pv_one(f32x16& od, int vb, bf16x8 pa0, bf16x8 pa1, bf16x8 pa2, bf16x8 pa3) {
#define PK(L, H) (bf16x8){L[0], L[1], L[2], L[3], H[0], H[1], H[2], H[3]}
  if constexpr (SPLIT) {
  {
    const s16x4 l0 = tr_read<v_rd_off(D0, 0, 0)>(vb), h0 = tr_read<v_rd_off(D0, 0, 1)>(vb), l1 = tr_read<v_rd_off(D0, 1, 0)>(vb), h1 = tr_read<v_rd_off(D0, 1, 1)>(vb);
    asm volatile("s_waitcnt lgkmcnt(0)" ::: "memory"); SBAR();
    od = __builtin_amdgcn_mfma_f32_32x32x16_bf16(pa0, PK(l0, h0), od, 0, 0, 0);
    od = __builtin_amdgcn_mfma_f32_32x32x16_bf16(pa1, PK(l1, h1), od, 0, 0, 0);
  }
  {
    const s16x4 l2 = tr_read<v_rd_off(D0, 2, 0)>(vb), h2 = tr_read<v_rd_off(D0, 2, 1)>(vb), l3 = tr_read<v_rd_off(D0, 3, 0)>(vb), h3 = tr_read<v_rd_off(D0, 3, 1)>(vb);
    asm volatile("s_waitcnt lgkmcnt(0)" ::: "memory"); SBAR();
    od = __builtin_amdgcn_mfma_f32_32x32x16_bf16(pa2, PK(l2, h2), od, 0, 0, 0);
    od = __builtin_amdgcn_mfma_f32_32x32x16_bf16(pa3, PK(l3, h3), od, 0, 0, 0);
  }
  } else {
    const s16x4 l0 = tr_read<v_rd_off(D0, 0, 0)>(vb), h0 = tr_read<v_rd_off(D0, 0, 1)>(vb), l1 = tr_read<v_rd_off(D0, 1, 0)>(vb), h1 = tr_read<v_rd_off(D0, 1, 1)>(vb);
    const s16x4 l2 = tr_read<v_rd_off(D0, 2, 0)>(vb), h2 = tr_read<v_rd_off(D0, 2, 1)>(vb), l3 = tr_read<v_rd_off(D0, 3, 0)>(vb), h3 = tr_read<v_rd_off(D0, 3, 1)>(vb);
    asm volatile("s_waitcnt lgkmcnt(0)" ::: "memory"); SBAR();
    od = __builtin_amdgcn_mfma_f32_32x32x16_bf16(pa0, PK(l0, h0), od, 0, 0, 0);
    od = __builtin_amdgcn_mfma_f32_32x32x16_bf16(pa1, PK(l1, h1), od, 0, 0, 0);
    od = __builtin_amdgcn_mfma_f32_32x32x16_bf16(pa2, PK(l2, h2), od, 0, 0, 0);
    od = __builtin_amdgcn_mfma_f32_32x32x16_bf16(pa3, PK(l3, h3), od, 0, 0, 0);
  }
#undef PK
}
template <bool SPLIT = true> DEV void pv_d0(f32x16* o, int vb, bf16x8 pa0, bf16x8 pa1, bf16x8 pa2, bf16x8 pa3) {
  pv_one<0, SPLIT>(o[0], vb, pa0, pa1, pa2, pa3); pv_one<1, SPLIT>(o[1], vb, pa0, pa1, pa2, pa3); pv_one<2, SPLIT>(o[2], vb, pa0, pa1, pa2, pa3); pv_one<3, SPLIT>(o[3], vb, pa0, pa1, pa2, pa3);
}

template <bool WIN>
DEV void partialSM(f32x16& p0, f32x16& p1, float& m_reg, float& mn, float& alpha, const float C, const float thr_raw, int kdiff) {
  if (WIN) {
#pragma unroll
    for (int r = 0; r < 16; ++r) {
      const int d = kdiff + (r & 3) + 8 * (r >> 2);
      if (d > 128 || d < -128) p0[r] = -INFINITY;
      if (d + 32 > 128 || d + 32 < -128) p1[r] = -INFINITY;
    }
  }
  float pmax = p0[0];
#pragma unroll
  for (int r = 1; r < 16; ++r) pmax = fmaxf(pmax, p0[r]);
#pragma unroll
  for (int r = 0; r < 16; ++r) pmax = fmaxf(pmax, p1[r]);
  { auto rr = __builtin_amdgcn_permlane32_swap(__float_as_uint(pmax), __float_as_uint(pmax), false, false);
    pmax = fmaxf(__uint_as_float(rr[0]), __uint_as_float(rr[1])); }
  if (__builtin_expect(__all(pmax - m_reg <= thr_raw), 1)) { mn = m_reg; alpha = 1.f; }
  else { mn = fmaxf(m_reg, pmax); alpha = __builtin_amdgcn_exp2f((m_reg - mn) * C); m_reg = mn; }
  const float mnC = -mn * C;
#pragma unroll
  for (int r = 0; r < 16; ++r) p0[r] = fmaf(p0[r], C, mnC);
#pragma unroll
  for (int r = 0; r < 16; ++r) p1[r] = fmaf(p1[r], C, mnC);
#pragma unroll
  for (int r = 0; r < 16; ++r) p0[r] = __builtin_amdgcn_exp2f(p0[r]);
}
DEV void finishSM(f32x16& p0, f32x16& p1, float alpha, float& l_reg, bf16x8& pa0, bf16x8& pa1, bf16x8& pa2, bf16x8& pa3) {
#pragma unroll
  for (int r = 0; r < 16; ++r) p1[r] = __builtin_amdgcn_exp2f(p1[r]);
  float ps = 0;
#pragma unroll
  for (int r = 0; r < 16; ++r) ps += p0[r];
#pragma unroll
  for (int r = 0; r < 16; ++r) ps += p1[r];
  { auto rr = __builtin_amdgcn_permlane32_swap(__float_as_uint(ps), __float_as_uint(ps), false, false);
    ps = __uint_as_float(rr[0]) + __uint_as_float(rr[1]); }
  l_reg = l_reg * alpha + ps;
#define PK4(P, BASE, OUT) do { unsigned a0 = cvtpk(P[BASE + 0], P[BASE + 1]), a1 = cvtpk(P[BASE + 2], P[BASE + 3]);   \
    unsigned b0 = cvtpk(P[BASE + 4], P[BASE + 5]), b1 = cvtpk(P[BASE + 6], P[BASE + 7]);                              \
    auto r0 = __builtin_amdgcn_permlane32_swap(a0, b0, false, false); auto r1 = __builtin_amdgcn_permlane32_swap(a1, b1, false, false); \
    u32x4 w = {r0[0], r1[0], r0[1], r1[1]}; OUT = *reinterpret_cast<bf16x8*>(&w); } while (0)
  PK4(p0, 0, pa0); PK4(p0, 8, pa1); PK4(p1, 0, pa2); PK4(p1, 8, pa3);
#undef PK4
}

template <int DQK> struct ACfg { static constexpr int KROW = DQK * 2 + 16, KT = 64 * KROW, NKP = (64 * (DQK / 8)) / NTHR, PPR = DQK / 8; };

template <int DQK, int NQR>
DEV void qkt(f32x16& p0, f32x16& p1, const char* Ks, const bf16x8* qr, const char* qlds_, int r32, int hi) {
  constexpr int KROW = ACfg<DQK>::KROW;
  unsigned qa = (unsigned)(uintptr_t)qlds_; asm volatile("" : "+v"(qa));
  const __attribute__((address_space(3))) char* qlds = (const __attribute__((address_space(3))) char*)qa;
#pragma unroll
  for (int r = 0; r < 16; ++r) { p0[r] = 0.f; p1[r] = 0.f; }
#pragma unroll
  for (int d0 = 0; d0 < DQK / 16; ++d0) {
    const int cb = (d0 * 16 + hi * 8) * 2;
    bf16x8 b0 = *reinterpret_cast<const bf16x8*>(Ks + r32 * KROW + cb);
    bf16x8 b1 = *reinterpret_cast<const bf16x8*>(Ks + (32 + r32) * KROW + cb);
    bf16x8 q;
    if (d0 < NQR) q = qr[d0 < NQR ? d0 : 0]; else q = *reinterpret_cast<const __attribute__((address_space(3))) bf16x8*>(qlds + (d0 - NQR) * 1024);
    p0 = __builtin_amdgcn_mfma_f32_32x32x16_bf16(b0, q, p0, 0, 0, 0);
    p1 = __builtin_amdgcn_mfma_f32_32x32x16_bf16(b1, q, p1, 0, 0, 0);
    if (NQR < DQK / 16 && (d0 & 3) == 3) SBAR();
  }
}

template <int DQK, bool WIN, bool TWO>
DEV void attn_unit(const bf16_t* Qb, int ldq, const bf16_t* __restrict__ Kh, int ldk, const bf16_t* __restrict__ Vh, int ldv,
                   bf16_t* Ob, int ldo, int kbeg, int NT, int q0, float sink, const float SCALE, char* lds) {
  using CF = ACfg<DQK>;
  constexpr int KROW = CF::KROW, KT = CF::KT, NKP = CF::NKP, PPR = CF::PPR, SHM_V = 16384;
  const float C = SCALE * 1.4426950408889634f, thr_raw = 8.f / SCALE;
  const int tid = ltid(), wid = tid >> 6, lane = tid & 63, r32 = lane & 31, hi = lane >> 5;
  char* V_lds = lds; char* K_lds = lds + 2 * SHM_V;
  float* wsf = (float*)(lds + 2 * SHM_V + 2 * KT) + wid * 64; float* li_l = wsf; float* al_l = wsf + 32;
  float m_reg = -1e30f, l_reg = 0;
  f32x16 o[4];
#pragma unroll
  for (int d = 0; d < 4; ++d)
#pragma unroll
    for (int r = 0; r < 16; ++r) o[d][r] = 0.f;
  constexpr int NQR = TWO ? 4 : DQK / 16;
  bf16x8 qr[NQR];
  const bf16_t* Qw = Qb + (size_t)(wid * 32 + r32) * ldq + hi * 8;
  char* qlds = lds + 2 * SHM_V + 2 * KT + 2048 + wid * 8192 + lane * 16;
#pragma unroll
  for (int d0 = 0; d0 < NQR; ++d0) qr[d0] = *(const bf16x8*)(Qw + d0 * 16);
#pragma unroll
  for (int d0 = NQR; d0 < DQK / 16; ++d0) *(bf16x8*)(qlds + (d0 - NQR) * 1024) = *(const bf16x8*)(Qw + d0 * 16);
  const int sr = tid >> 4, sc = (tid & 15) * 8, vst0 = v_st(sr, sc), vst1 = v_st(32 + sr, sc);
  const int vb0 = (int)(uintptr_t)V_lds + v_rd_base(lane);
  const unsigned voff = (unsigned)(sr * ldv + sc) * 2u, vstep = (unsigned)ldv * 64u;
  unsigned koff[NKP]; int klds[NKP];
#pragma unroll
  for (int i = 0; i < NKP; ++i) { const int p = tid + i * NTHR; const int kr = p / PPR, kc = (p % PPR) * 8; koff[i] = (unsigned)(kr * ldk + kc) * 2u; klds[i] = kr * KROW + kc * 2; }
  const int qpos = q0 + wid * 32 + r32;
  bf16x8 svs0, svs1, sks[NKP];
#define SLOAD(k0) do { const char* Vt_ = (const char*)(Vh + (size_t)(k0) * ldv); const char* Kt_ = (const char*)(Kh + (size_t)(k0) * ldk); \
    svs0 = *(const bf16x8*)(Vt_ + voff); svs1 = *(const bf16x8*)(Vt_ + vstep + voff); \
    _Pragma("unroll") for (int i_ = 0; i_ < NKP; ++i_) sks[i_] = *(const bf16x8*)(Kt_ + koff[i_]); } while (0)
#define SWRITE(b) do { *(bf16x8*)(V_lds + (b) * SHM_V + vst0) = svs0; *(bf16x8*)(V_lds + (b) * SHM_V + vst1) = svs1; \
    _Pragma("unroll") for (int i_ = 0; i_ < NKP; ++i_) *(bf16x8*)(K_lds + (b) * KT + klds[i_]) = sks[i_]; } while (0)
#define SWAIT() asm volatile("s_waitcnt vmcnt(0)" ::: "memory")
#define RESC(a) do { if (__any((a) < 1.f)) { if (hi == 0) al_l[r32] = (a); asm volatile("s_waitcnt lgkmcnt(0)" ::: "memory"); \
    _Pragma("unroll") for (int d = 0; d < 4; ++d) _Pragma("unroll") for (int r = 0; r < 16; ++r) o[d][r] *= al_l[crow(r, hi)]; } } while (0)
#define KDIFF(t) (kbeg + (t) * 64 + 4 * hi - qpos)
  bf16x8 pa0, pa1, pa2, pa3;
  if constexpr (TWO) {
  f32x16 pA0, pA1, pB0, pB1; float mnA, mnB, alA, alB;
  SLOAD(kbeg); SWAIT(); SWRITE(0); SLOAD(kbeg + 64); __syncthreads();
  qkt<DQK, NQR>(pA0, pA1, K_lds, qr, qlds, r32, hi); partialSM<WIN>(pA0, pA1, m_reg, mnA, alA, C, thr_raw, KDIFF(0));
  SWAIT(); SWRITE(1); __syncthreads();
  for (int j = 1; j + 1 < NT; j += 2) {
    SBAR(); qkt<DQK, NQR>(pB0, pB1, K_lds + KT, qr, qlds, r32, hi);
    finishSM(pA0, pA1, alA, l_reg, pa0, pa1, pa2, pa3); SBAR();
    SLOAD(kbeg + (j + 1) * 64); SBAR();
    pv_d0(o, vb0, pa0, pa1, pa2, pa3); partialSM<WIN>(pB0, pB1, m_reg, mnB, alB, C, thr_raw, KDIFF(j));
    __syncthreads(); SWAIT(); SWRITE(0);
    RESC(alB); __syncthreads();
    SBAR(); qkt<DQK, NQR>(pA0, pA1, K_lds, qr, qlds, r32, hi);
    finishSM(pB0, pB1, alB, l_reg, pa0, pa1, pa2, pa3); SBAR();
    SLOAD(kbeg + (j + 2) * 64); SBAR();
    pv_d0(o, vb0 + SHM_V, pa0, pa1, pa2, pa3); partialSM<WIN>(pA0, pA1, m_reg, mnA, alA, C, thr_raw, KDIFF(j + 1));
    __syncthreads(); SWAIT(); SWRITE(1);
    RESC(alA); __syncthreads();
  }
  SBAR(); qkt<DQK, NQR>(pB0, pB1, K_lds + KT, qr, qlds, r32, hi);
  finishSM(pA0, pA1, alA, l_reg, pa0, pa1, pa2, pa3); SBAR();
  pv_d0(o, vb0, pa0, pa1, pa2, pa3); partialSM<WIN>(pB0, pB1, m_reg, mnB, alB, C, thr_raw, KDIFF(NT - 1));
  __syncthreads(); RESC(alB);
  finishSM(pB0, pB1, alB, l_reg, pa0, pa1, pa2, pa3); SBAR();
  pv_d0(o, vb0 + SHM_V, pa0, pa1, pa2, pa3);
  } else {
  f32x16 pA0, pA1; float mnA, alA;
  SLOAD(kbeg); SWAIT(); SWRITE(0); __syncthreads();
  for (int j = 0; j < NT; ++j) {
    const int bf = j & 1;
    if (j + 1 < NT) SLOAD(kbeg + (j + 1) * 64);
    SBAR(); qkt<DQK, NQR>(pA0, pA1, K_lds + bf * KT, qr, qlds, r32, hi);
    partialSM<WIN>(pA0, pA1, m_reg, mnA, alA, C, thr_raw, KDIFF(j));
    RESC(alA);
    finishSM(pA0, pA1, alA, l_reg, pa0, pa1, pa2, pa3); SBAR();
    if (j + 1 < NT) { SWAIT(); if (bf) SWRITE(0); else SWRITE(1); }
    SBAR();
    pv_d0<false>(o, vb0 + bf * SHM_V, pa0, pa1, pa2, pa3);
    __syncthreads();
  }
  }
  if (WIN) l_reg += __builtin_amdgcn_exp2f(sink * 1.4426950408889634f - m_reg * C);
  if (hi == 0) li_l[r32] = l_reg; asm volatile("s_waitcnt lgkmcnt(0)" ::: "memory");
  const unsigned obase = (unsigned)((wid * 32 + 4 * hi) * ldo + r32) * 2u;
#pragma unroll
  for (int r = 0; r < 16; ++r) {
    const int dr = (r & 3) + 8 * (r >> 2); const float rl = __builtin_amdgcn_rcpf(li_l[dr + 4 * hi]);
    char* op = (char*)Ob + (obase + (unsigned)(dr * ldo) * 2u);
#pragma unroll
    for (int d0 = 0; d0 < 4; ++d0) *(bf16_t*)(op + d0 * 64) = f2bf(o[d0][r] * rl);
  }
  __syncthreads();
#undef SLOAD
#undef SWRITE
#undef SWAIT
#undef RESC
#undef KDIFF
}

DEV void gmlp_unit(int chunk, bf16_t* PROJ, const bf16_t* WSs, const float* __restrict__ ln_g, const float* __restrict__ ln_b, const float* __restrict__ b_s, char* lds) {
  const int tid = ltid(), wid = tid >> 6, lane = tid & 63, r32 = lane & 31, hi = lane >> 5;
  float* stats = (float*)(lds + 65536);
  const size_t t0 = (size_t)chunk * 128;
  for (int rr = 0; rr < 16; ++rr) {
    const int row = wid * 16 + rr;
    const bf16_t* vp = PROJ + (t0 + row) * INP + C_V;
    const u32x4 x0 = *(const u32x4*)(vp + lane * 8), x1 = *(const u32x4*)(vp + 512 + lane * 8);
    float s = 0.f, q = 0.f;
#pragma unroll
    for (int i = 0; i < 4; ++i) { float a = bflo(x0[i]), b = bfhi(x0[i]), c = bflo(x1[i]), d = bfhi(x1[i]); s += (a + b) + (c + d); q += (a * a + b * b) + (c * c + d * d); }
#pragma unroll
    for (int off = 32; off > 0; off >>= 1) { s += __shfl_xor(s, off); q += __shfl_xor(q, off); }
    if (lane == 0) { const float mean = s * (1.f / 1024.f); const float var = fmaxf(q * (1.f / 1024.f) - mean * mean, 0.f); stats[row * 2] = mean; stats[row * 2 + 1] = rsqrtf(var + EPS); }
  }
  __syncthreads();
  const int mi = wid & 3, wc = wid >> 2;
  const int vb = (int)(uintptr_t)lds + v_rd_base(lane) + wc * 1024;
  u32x4 xs[4];
#define GM_LOAD(g_) do { _Pragma("unroll") for (int i = 0; i < 4; ++i) { const int p = tid + i * NTHR, k = p >> 4, c = (p & 15) * 8; \
      xs[i] = *(const u32x4*)(PROJ + (t0 + k) * INP + C_V + (g_) * 128 + c); } } while (0)
#define GM_STAGE(g_) do { char* tb_ = lds + ((g_) & 1) * 32768; _Pragma("unroll") for (int i = 0; i < 4; ++i) { const int p = tid + i * NTHR, k = p >> 4, c = (p & 15) * 8; \
      const u32x4 x = xs[i]; const float mean = stats[k * 2], rstd = stats[k * 2 + 1]; \
      const f32x4 g0 = *(const f32x4*)(ln_g + (g_) * 128 + c), g1 = *(const f32x4*)(ln_g + (g_) * 128 + c + 4); \
      const f32x4 b0 = *(const f32x4*)(ln_b + (g_) * 128 + c), b1 = *(const f32x4*)(ln_b + (g_) * 128 + c + 4); \
      u32x4 w; \
      w[0] = cvtpk((bflo(x[0]) - mean) * rstd * g0[0] + b0[0], (bfhi(x[0]) - mean) * rstd * g0[1] + b0[1]); \
      w[1] = cvtpk((bflo(x[1]) - mean) * rstd * g0[2] + b0[2], (bfhi(x[1]) - mean) * rstd * g0[3] + b0[3]); \
      w[2] = cvtpk((bflo(x[2]) - mean) * rstd * g1[0] + b1[0], (bfhi(x[2]) - mean) * rstd * g1[1] + b1[1]); \
      w[3] = cvtpk((bflo(x[3]) - mean) * rstd * g1[2] + b1[2], (bfhi(x[3]) - mean) * rstd * g1[3] + b1[3]); \
      *(u32x4*)(tb_ + (k >> 6) * 16384 + v_st(k & 63, c)) = w; } } while (0)
  GM_LOAD(0); GM_STAGE(0);
  __syncthreads();
  for (int g = 0; g < 8; ++g) {
    if (g + 1 < 8) GM_LOAD(g + 1);
    bf16x8 a[8];
#pragma unroll
    for (int ks = 0; ks < 8; ++ks) a[ks] = *(const bf16x8*)(WSs + (size_t)g * 16384 + (32 * mi + r32) * 128 + ks * 16 + hi * 8);
    const int vbg = vb + (g & 1) * 32768;
    f32x16 od[2];
#pragma unroll
    for (int r = 0; r < 16; ++r) { od[0][r] = 0.f; od[1][r] = 0.f; }
    pv_one<0>(od[0], vbg, a[0], a[1], a[2], a[3]); pv_one<0>(od[0], vbg + 16384, a[4], a[5], a[6], a[7]);
    pv_one<1>(od[1], vbg, a[0], a[1], a[2], a[3]); pv_one<1>(od[1], vbg + 16384, a[4], a[5], a[6], a[7]);
    if (g + 1 < 8) GM_STAGE(g + 1);
#pragma unroll
    for (int r = 0; r < 16; ++r) {
      const int row = 32 * mi + crow(r, hi); const float bs = b_s[g * 128 + row];
#pragma unroll
      for (int d = 0; d < 2; ++d) {
        bf16_t* up = PROJ + (t0 + row) * INP + C_U + g * 128 + wc * 64 + d * 32 + r32;
        *up = f2bf(bf2f(*up) * (od[d][r] + bs));
      }
    }
    __syncthreads();
  }
#undef GM_LOAD
#undef GM_STAGE
}

DEV void phase_cvt(const float* __restrict__ x, bf16_t* __restrict__ h, float* __restrict__ rs, int T, int gwave, int nwaves, int lane) {
  for (int row = gwave; row < T; row += nwaves) {
    f32x4 v[4]; float ss = 0.f;
#pragma unroll
    for (int i = 0; i < 4; ++i) { v[i] = __builtin_nontemporal_load((const f32x4*)(x + (size_t)row * 1024 + i * 256 + lane * 4)); ss += (v[i][0] * v[i][0] + v[i][1] * v[i][1]) + (v[i][2] * v[i][2] + v[i][3] * v[i][3]); }
#pragma unroll
    for (int off = 32; off > 0; off >>= 1) ss += __shfl_xor(ss, off);
    if (lane == 0) rs[row] = rsqrtf(ss * (1.f / 1024.f) + EPS);
#pragma unroll
    for (int i = 0; i < 4; ++i) { u32x2 w = {cvtpk(v[i][0], v[i][1]), cvtpk(v[i][2], v[i][3])}; *(u32x2*)(h + (size_t)row * 1024 + i * 256 + lane * 4) = w; }
  }
}
DEV void phase_resnorm(const bf16_t* __restrict__ y, const float* xin, const float* __restrict__ gain, float* xout, bf16_t* __restrict__ h, float* __restrict__ rsout, int T, int gwave, int nwaves, int lane) {
  constexpr int NB = 4;
  f32x4 gg[4];
#pragma unroll
  for (int i = 0; i < 4; ++i) gg[i] = *(const f32x4*)(gain + i * 256 + lane * 4);
  for (int row0 = gwave; row0 < T; row0 += NB * nwaves) {
    u32x2 yw[NB][4]; f32x4 xi[NB][4]; float ss[NB], s2[NB];
#pragma unroll
    for (int j = 0; j < NB; ++j)
#pragma unroll
      for (int i = 0; i < 4; ++i) yw[j][i] = *(const u32x2*)(y + (size_t)(row0 + j * nwaves) * 1024 + i * 256 + lane * 4);
#pragma unroll
    for (int j = 0; j < NB; ++j)
#pragma unroll
      for (int i = 0; i < 4; ++i) xi[j][i] = *(const f32x4*)(xin + (size_t)(row0 + j * nwaves) * 1024 + i * 256 + lane * 4);
#pragma unroll
    for (int j = 0; j < NB; ++j) { ss[j] = 0.f;
#pragma unroll
      for (int i = 0; i < 4; ++i) { const float a = bflo(yw[j][i][0]), b2 = bfhi(yw[j][i][0]), c = bflo(yw[j][i][1]), d = bfhi(yw[j][i][1]); ss[j] += (a * a + b2 * b2) + (c * c + d * d); } }
#pragma unroll
    for (int off = 32; off > 0; off >>= 1)
#pragma unroll
      for (int j = 0; j < NB; ++j) ss[j] += __shfl_xor(ss[j], off);
#pragma unroll
    for (int j = 0; j < NB; ++j) {
      const float rstd = rsqrtf(ss[j] * (1.f / 1024.f) + EPS); const size_t ro = (size_t)(row0 + j * nwaves) * 1024; s2[j] = 0.f;
#pragma unroll
      for (int i = 0; i < 4; ++i) {
        const int c = i * 256 + lane * 4;
        f32x4 o; o[0] = xi[j][i][0] + bflo(yw[j][i][0]) * rstd * gg[i][0]; o[1] = xi[j][i][1] + bfhi(yw[j][i][0]) * rstd * gg[i][1];
        o[2] = xi[j][i][2] + bflo(yw[j][i][1]) * rstd * gg[i][2]; o[3] = xi[j][i][3] + bfhi(yw[j][i][1]) * rstd * gg[i][3];
        s2[j] += (o[0] * o[0] + o[1] * o[1]) + (o[2] * o[2] + o[3] * o[3]);
        __builtin_nontemporal_store(o, (f32x4*)(xout + ro + c));
        if (h) { u32x2 w = {cvtpk(o[0], o[1]), cvtpk(o[2], o[3])}; *(u32x2*)(h + ro + c) = w; }
      }
    }
    if (rsout) {
#pragma unroll
      for (int off = 32; off > 0; off >>= 1)
#pragma unroll
        for (int j = 0; j < NB; ++j) s2[j] += __shfl_xor(s2[j], off);
      if (lane == 0) {
#pragma unroll
        for (int j = 0; j < NB; ++j) rsout[row0 + j * nwaves] = rsqrtf(s2[j] * (1.f / 1024.f) + EPS);
      }
    }
  }
}

enum { MAP_ID = 0, MAP_IN = 1, MAP_UQ = 2, MAP_GU = 3 };
template <int MAP>
DEV void prep_w(bf16_t* __restrict__ dst, int Nd, int K, const float* __restrict__ src, const float* __restrict__ src2, int Ns, const float* __restrict__ gain, int gtid, int gsz) {
  const int kbn = K >> 3; const long total = (long)Nd * kbn;
  for (long idx = gtid; idx < total; idx += gsz) {
    const int n = (int)(idx % Nd), kb = (int)(idx / Nd);
    const float* s = src; int sc = n; bool zero = false;
    if (MAP == MAP_IN) {
      if (n >= C_END) zero = true;
      else if (n >= C_Q && n < C_VV) { const int j = (n - C_Q) & 127; sc = n - j + (j >> 1) + 64 * (j & 1); }
      else if (n >= C_KR && n < C_Q) { const int j = n - C_KR; sc = C_KR + (j >> 1) + 32 * (j & 1); }
    } else if (MAP == MAP_UQ) {
      const int h = n / 192, j = n % 192;
      if (j >= 128) { const int jj = j - 128; sc = h * 192 + 128 + (jj >> 1) + 32 * (jj & 1); }
    } else if (MAP == MAP_GU) {
      const int b = n >> 8, j = n & 255;
      if (j < 128) sc = b * 128 + j; else { s = src2; sc = b * 128 + j - 128; }
    }
    float v[8];
#pragma unroll
    for (int i = 0; i < 8; ++i) { const int k = kb * 8 + i; v[i] = zero ? 0.f : s[(size_t)k * Ns + sc] * (gain ? gain[k] : 1.f); }
    u32x4 w = {cvtpk(v[0], v[1]), cvtpk(v[2], v[3]), cvtpk(v[4], v[5]), cvtpk(v[6], v[7])};
    *(u32x4*)(dst + (size_t)n * K + kb * 8) = w;
  }
}

template <int KIND>
DEV void p2_epi(const f32x16& a, const float* rs, bf16_t* PROJ, unsigned ob, bf16_t* KM, const float2* RT, int pos0, int col) {
#pragma unroll
  for (int r = 0; r < 16; ++r) {
    const int dr = (r & 3) + 8 * (r >> 2);
    float v = a[r] * rs[dr];
    if (KIND == 0) PROJ[ob + dr * INP] = f2bf(gelu_t(v));
    else if (KIND == 1) PROJ[ob + dr * INP] = f2bf(v);
    else if (KIND == 4) PROJ[ob + dr * INP] = f2bf(sigm(v));
    else if (KIND == 3) {
      const float pr = __shfl_xor(v, 1); const int j = (col - C_Q) & 127;
      const float2 cs = RT[(pos0 + dr) * 64 + (j >> 1)];
      PROJ[ob + dr * INP] = f2bf((j & 1) ? (v * cs.x + pr * cs.y) : (v * cs.x - pr * cs.y));
    } else {
      const float pr = __shfl_xor(v, 1); const int j = col - C_KR;
      const float2 cs = RT[(pos0 + dr) * 32 + (j >> 1)];
      const bf16_t o = f2bf((j & 1) ? (v * cs.x + pr * cs.y) : (v * cs.x - pr * cs.y));
#pragma unroll
      for (int h = 0; h < 8; ++h) KM[ob + dr * 1536 + h * 192 + 128 + j] = o;
    }
  }
}
namespace pg8 {
#define PG8_LAS __attribute__((address_space(3)))
typedef unsigned short bf16_t;
typedef short bf16x8 __attribute__((ext_vector_type(8)));
typedef float f32x4 __attribute__((ext_vector_type(4)));
typedef unsigned u32x4 __attribute__((ext_vector_type(4)));
constexpr int BM = 256, BK = 64, HALF = 128, HTB = HALF * BK * 2  , STAGE_BYTES = 8 * HTB, NXCD = 8, WGM = 8;

__host__ __device__ __forceinline__ int lds_byte(int r, int c) { const int st = (r >> 4) * 2 + (c >> 5), rr = r & 15, cc = c & 31, ob = rr * 64 + cc * 2; return st * 1024 + (ob ^ (((ob >> 9) & 1) << 5)); }
__host__ __device__ __forceinline__ void stage_rc(int b, int& R, int& C) { const int st = b / 1024, sb = b % 1024, swz = sb ^ (((sb >> 9) & 1) << 5); R = (st >> 1) * 16 + swz / 64; C = (st & 1) * 32 + (swz % 64) / 2; }
__host__ __device__ __forceinline__ int perm32(int rho) { const int n = rho >> 4, i = rho & 15; return 8 * (i >> 2) + 4 * n + (i & 3); }

struct Unit { int pm, pn; };
struct Gemm { const bf16_t* A; const bf16_t* Bt; int M, N, K; };

struct StaticOrder {
    int nM, nN, nwg, G, c;
    __host__ __device__ void init(int M, int N, int G_, int c_) { nM = M / BM; nN = N / BM; nwg = nM * nN; G = G_; c = c_; }
    __host__ __device__ bool next(int i, Unit& u) const {
        const long L = (long)i * G + c; if (L >= nwg) return false;
        int wgid = (int)L; { const int q = nwg / NXCD, r = nwg % NXCD, xcd = wgid % NXCD, off = wgid / NXCD; wgid = (xcd < r ? xcd * (q + 1) : r * (q + 1) + (xcd - r) * q) + off; }
        const int nig = WGM * nN, gid = wgid / nig, fm = gid * WGM, gsz = (nM - fm) < WGM ? (nM - fm) : WGM;
        u.pm = fm + ((wgid % nig) % gsz); u.pn = (wgid % nig) / gsz; return true;
    }
    __device__ __forceinline__ void a_ready(const Unit&) const {}
    __device__ __forceinline__ void done(const Unit&) const {}
};


template <class Epi, class Sched, bool ALIGN_EPI = false, bool SP2 = false>
__device__ __forceinline__ void gemm_phase(PG8_LAS unsigned char* lds, const Gemm g, const Sched& S, const Epi& E, const int lda_in = 0) {
    const int tid = ltid(), wid = __builtin_amdgcn_readfirstlane(tid >> 6), lane = tid & 63, wr = wid >> 2, wc = wid & 3, fr = lane & 15, fq = lane >> 4;
    const int K = g.K, nt = K / BK, lda = lda_in ? lda_in : K;
    unsigned voffA[2], voffB[2];
#pragma unroll
    for (int i = 0; i < 2; ++i) { int R, C; stage_rc(tid * 16 + i * 8192, R, C); const int Rb = Epi::PERM ? ((R & ~31) + perm32(R & 31)) : R;
        voffA[i] = (unsigned)(R * lda + C) * 2u; voffB[i] = (unsigned)(Rb * K + C) * 2u; }
    const size_t kstep = (size_t)(BK * 2);
    const size_t hstep = (size_t)HALF * K * 2;
    const size_t tstep = 2 * hstep;
    const size_t hstepA = (size_t)HALF * lda * 2, tstepA = 2 * hstepA;
    const unsigned ldsw = (unsigned)wid * 1024u;
    const int aoff = lds_byte(wr * 64 + fr, fq * 8), boff = lds_byte(wc * 32 + fr, fq * 8);
#define PG8_SA(b, h) (((b) * 2 + (h)) * HTB)
#define PG8_SB(b, h) ((4 + (b) * 2 + (h)) * HTB)
#define PG8_STAGE(bufoff, gbase, voff) do { _Pragma("unroll") for (int _i = 0; _i < 2; ++_i) \
        __builtin_amdgcn_global_load_lds((const unsigned*)((const char*)(gbase) + (voff)[_i]), (PG8_LAS unsigned*)(lds + (bufoff) + ldsw + _i * 8192), 16, 0, 0); } while (0)
#define PG8_LDA(dst, b, h) do { _Pragma("unroll") for (int m = 0; m < 4; ++m) _Pragma("unroll") for (int k = 0; k < 2; ++k) dst[m][k] = *(const PG8_LAS bf16x8*)(lds + PG8_SA(b, h) + aoff + m * 2048 + k * 1024); } while (0)
#define PG8_LDB(dst, b, h) do { _Pragma("unroll") for (int n = 0; n < 2; ++n) _Pragma("unroll") for (int k = 0; k < 2; ++k) dst[n][k] = *(const PG8_LAS bf16x8*)(lds + PG8_SB(b, h) + boff + n * 2048 + k * 1024); } while (0)
#define PG8_MMA(ai, bj, At, Bt) do { __builtin_amdgcn_s_setprio(1); _Pragma("unroll") for (int m = 0; m < 4; ++m) _Pragma("unroll") for (int n = 0; n < 2; ++n) _Pragma("unroll") for (int k = 0; k < 2; ++k) \
        acc[ai][bj][m][n] = __builtin_amdgcn_mfma_f32_16x16x32_bf16(Bt[n][k], At[m][k], acc[ai][bj][m][n], 0, 0, 0); __builtin_amdgcn_s_setprio(0); } while (0)
#define PG8_WAIT_V(n) asm volatile("s_waitcnt vmcnt(" #n ")" ::: "memory")
#define PG8_WAIT_L(n) asm volatile("s_waitcnt lgkmcnt(" #n ")" ::: "memory")
#define PG8_BAR __builtin_amdgcn_s_barrier()
#define PG8_SCHED __builtin_amdgcn_sched_barrier(0)
    Unit cur, nxt; int ui = 0;
    if (!S.next(0, cur)) return;
    f32x4 acc[2][2][4][2];
#pragma unroll
    for (int a = 0; a < 2; ++a)
#pragma unroll
        for (int b = 0; b < 2; ++b)
#pragma unroll
            for (int m = 0; m < 4; ++m)
#pragma unroll
                for (int n = 0; n < 2; ++n) acc[a][b][m][n] = (f32x4){0.f, 0.f, 0.f, 0.f};
    bf16x8 At[4][2], B0[2][2], B1[2][2];
    const char* cA = (const char*)g.A + (size_t)cur.pm * tstepA; const char* cB = (const char*)g.Bt + (size_t)cur.pn * tstep;
    S.a_ready(cur);
    if constexpr (SP2) {
        PG8_STAGE(PG8_SB(0, 0), cB, voffB); PG8_STAGE(PG8_SB(0, 1), cB + hstep, voffB); PG8_STAGE(PG8_SA(0, 0), cA, voffA); PG8_STAGE(PG8_SA(0, 1), cA + hstepA, voffA);
        if (wr == 1) PG8_BAR;
        PG8_WAIT_V(2); PG8_BAR;
        PG8_STAGE(PG8_SB(1, 0), cB + kstep, voffB); PG8_STAGE(PG8_SA(1, 0), cA + kstep, voffA); PG8_STAGE(PG8_SB(1, 1), cB + hstep + kstep, voffB);
        PG8_WAIT_V(6); PG8_BAR;
    } else {
        PG8_STAGE(PG8_SB(0, 0), cB, voffB); PG8_STAGE(PG8_SA(0, 0), cA, voffA); PG8_STAGE(PG8_SB(0, 1), cB + hstep, voffB); PG8_STAGE(PG8_SA(0, 1), cA + hstepA, voffA);
        if (wr == 1) PG8_BAR;
        PG8_WAIT_V(4); PG8_BAR;
        PG8_STAGE(PG8_SB(1, 0), cB + kstep, voffB); PG8_STAGE(PG8_SA(1, 0), cA + kstep, voffA); PG8_STAGE(PG8_SB(1, 1), cB + hstep + kstep, voffB);
        PG8_WAIT_V(6); PG8_BAR;
    }
    for (;;) {
        const bool has_next = S.next(ui + 1, nxt);
        const char* nA = has_next ? (const char*)g.A + (size_t)nxt.pm * tstepA : cA; const char* nB = has_next ? (const char*)g.Bt + (size_t)nxt.pn * tstep : cB;
        for (int t = 0; t < nt; t += 2) {
            const bool last = (t == nt - 2);
            const char* a1 = cA + (size_t)(t + 1) * kstep;
            const char* a2 = last ? nA : cA + (size_t)(t + 2) * kstep; const char* b2 = last ? nB : cB + (size_t)(t + 2) * kstep;
            const char* a3 = a2 + kstep; const char* b3 = b2 + kstep;
            if (last && has_next) S.a_ready(nxt);
            if constexpr (SP2) {
            PG8_LDB(B0, 0, 0); PG8_LDB(B1, 0, 1); PG8_SCHED; PG8_LDA(At, 0, 0); PG8_STAGE(PG8_SA(1, 1), a1 + hstepA, voffA);
            PG8_WAIT_V(8); PG8_WAIT_L(0); PG8_BAR; PG8_MMA(0, 0, At, B0); PG8_MMA(0, 1, At, B1); PG8_BAR; PG8_SCHED;
            PG8_LDA(At, 0, 1); PG8_STAGE(PG8_SB(0, 0), b2, voffB); PG8_STAGE(PG8_SB(0, 1), b2 + hstep, voffB); PG8_STAGE(PG8_SA(0, 0), a2, voffA);
            PG8_WAIT_V(8); PG8_WAIT_L(0); PG8_BAR; PG8_MMA(1, 0, At, B0); PG8_MMA(1, 1, At, B1); PG8_BAR; PG8_SCHED;
            PG8_LDB(B0, 1, 0); PG8_LDB(B1, 1, 1); PG8_SCHED; PG8_LDA(At, 1, 0); PG8_STAGE(PG8_SA(0, 1), a2 + hstepA, voffA);
            PG8_WAIT_V(8); PG8_WAIT_L(0); PG8_BAR; PG8_MMA(0, 0, At, B0); PG8_MMA(0, 1, At, B1); PG8_BAR; PG8_SCHED;
            PG8_LDA(At, 1, 1); PG8_STAGE(PG8_SB(1, 0), b3, voffB); PG8_STAGE(PG8_SB(1, 1), b3 + hstep, voffB); PG8_STAGE(PG8_SA(1, 0), a3, voffA);
            PG8_WAIT_V(8); PG8_WAIT_L(0); PG8_BAR; PG8_MMA(1, 0, At, B0); PG8_MMA(1, 1, At, B1); PG8_BAR; PG8_SCHED;
            } else {
            PG8_LDB(B0, 0, 0); PG8_SCHED; PG8_LDA(At, 0, 0); PG8_STAGE(PG8_SA(1, 1), a1 + hstepA, voffA);
            PG8_WAIT_L(8); PG8_BAR; PG8_WAIT_L(0); PG8_MMA(0, 0, At, B0); PG8_BAR; PG8_SCHED;
            PG8_LDB(B1, 0, 1); PG8_STAGE(PG8_SB(0, 0), b2, voffB);
            PG8_BAR; PG8_WAIT_L(0); PG8_MMA(0, 1, At, B1); PG8_BAR;
            PG8_LDA(At, 0, 1); PG8_STAGE(PG8_SA(0, 0), a2, voffA);
            PG8_BAR; PG8_WAIT_L(0); PG8_MMA(1, 0, At, B0); PG8_BAR; PG8_SCHED;
            PG8_STAGE(PG8_SB(0, 1), b2 + hstep, voffB);
            PG8_WAIT_V(6); PG8_BAR; PG8_MMA(1, 1, At, B1); PG8_BAR;
            PG8_LDB(B0, 1, 0); PG8_SCHED; PG8_LDA(At, 1, 0); PG8_STAGE(PG8_SA(0, 1), a2 + hstepA, voffA);
            PG8_WAIT_L(8); PG8_BAR; PG8_WAIT_L(0); PG8_MMA(0, 0, At, B0); PG8_BAR; PG8_SCHED;
            PG8_LDB(B1, 1, 1); PG8_STAGE(PG8_SB(1, 0), b3, voffB);
            PG8_BAR; PG8_WAIT_L(0); PG8_MMA(0, 1, At, B1); PG8_BAR;
            PG8_LDA(At, 1, 1); PG8_STAGE(PG8_SA(1, 0), a3, voffA);
            PG8_BAR; PG8_WAIT_L(0); PG8_MMA(1, 0, At, B0); PG8_BAR; PG8_SCHED;
            PG8_STAGE(PG8_SB(1, 1), b3 + hstep, voffB);
            PG8_WAIT_V(6); PG8_BAR; PG8_MMA(1, 1, At, B1); PG8_BAR;
            }
        }
        if constexpr (ALIGN_EPI) { if (wr == 0) PG8_BAR; }
        if constexpr (!Epi::AFTER_DRAIN) { E(acc, cur, wr, wc, fr, fq); S.done(cur); }
        if (!has_next) break;
#pragma unroll
        for (int a = 0; a < 2; ++a)
#pragma unroll
            for (int b = 0; b < 2; ++b)
#pragma unroll
                for (int m = 0; m < 4; ++m)
#pragma unroll
                    for (int n = 0; n < 2; ++n) acc[a][b][m][n] = (f32x4){0.f, 0.f, 0.f, 0.f};
        cur = nxt; cA = nA; cB = nB; ++ui;
        if constexpr (ALIGN_EPI) { if (wr == 1) PG8_BAR; }
    }
    PG8_WAIT_V(0);
    if constexpr (!ALIGN_EPI) { if (wr == 0) PG8_BAR; }
    PG8_BAR;
    if constexpr (Epi::AFTER_DRAIN) { E.fused(acc, cur, wr, wc, fr, fq, lds, wid, lane); S.done(cur); }
#undef PG8_SA
#undef PG8_SB
#undef PG8_STAGE
#undef PG8_LDA
#undef PG8_LDB
#undef PG8_MMA
#undef PG8_WAIT_V
#undef PG8_WAIT_L
#undef PG8_BAR
#undef PG8_SCHED
}
}


struct EpiF32 {
  static constexpr bool PERM = false, AFTER_DRAIN = false;
  bf16_t* OUT;
  __device__ __forceinline__ void operator()(const pg8::f32x4 (&acc)[2][2][4][2], const pg8::Unit& u, int wr, int wc, int fr, int fq) const {
#pragma unroll
    for (int ai = 0; ai < 2; ++ai)
#pragma unroll
      for (int m = 0; m < 4; ++m) {
        bf16_t* rp = OUT + (size_t)(u.pm * 256 + ai * 128 + wr * 64 + m * 16 + fr) * 1024 + u.pn * 256 + wc * 32 + 4 * fq;
#pragma unroll
        for (int bj = 0; bj < 2; ++bj)
#pragma unroll
          for (int n = 0; n < 2; ++n) { const pg8::f32x4 v = acc[ai][bj][m][n]; u32x2 w; w[0] = cvtpk(v[0], v[1]); w[1] = cvtpk(v[2], v[3]); *(u32x2*)(rp + bj * 128 + n * 16) = w; }
      }
  }
};
struct EpiSwiGLU {
  static constexpr bool PERM = false, AFTER_DRAIN = false;
  bf16_t* TT; const float* RS;
  __device__ __forceinline__ void operator()(const pg8::f32x4 (&acc)[2][2][4][2], const pg8::Unit& u, int wr, int wc, int fr, int fq) const {
#pragma unroll
    for (int ai = 0; ai < 2; ++ai)
#pragma unroll
      for (int m = 0; m < 4; ++m) {
        const int row = u.pm * 256 + ai * 128 + wr * 64 + m * 16 + fr; const float rs = RS[row];
        bf16_t* rp = TT + (size_t)row * DFF + u.pn * 128 + wc * 32 + 4 * fq;
#pragma unroll
        for (int n = 0; n < 2; ++n) {
          const pg8::f32x4 g = acc[ai][0][m][n] * rs, uu = acc[ai][1][m][n] * rs;
          u32x2 w; w[0] = cvtpk(g[0] * sigm(g[0]) * uu[0], g[1] * sigm(g[1]) * uu[1]); w[1] = cvtpk(g[2] * sigm(g[2]) * uu[2], g[3] * sigm(g[3]) * uu[3]);
          *(u32x2*)(rp + n * 16) = w;
        }
      }
  }
};
struct EpiIn {
  static constexpr bool PERM = true, AFTER_DRAIN = false;
  bf16_t* PROJ; bf16_t* KM; const float2* R64; const float2* R128; const float* RS; int seqmask;
  __device__ __forceinline__ void operator()(const pg8::f32x4 (&acc)[2][2][4][2], const pg8::Unit& u, int wr, int wc, int fr, int fq) const {
#pragma unroll
    for (int bj = 0; bj < 2; ++bj) {
      const int cb = u.pn * 256 + bj * 128 + wc * 32;
      if (cb >= C_END) continue;
      const int kind = cb < C_CQL ? 0 : ((cb < C_KR || (cb >= C_VV && cb < C_G)) ? 1 : (cb < C_Q ? 2 : (cb < C_VV ? 3 : 4)));
      const int c0 = cb + 8 * fq;
#pragma unroll
      for (int ai = 0; ai < 2; ++ai)
#pragma unroll
        for (int m = 0; m < 4; ++m) {
          const int row = u.pm * 256 + ai * 128 + wr * 64 + m * 16 + fr; const float rs = RS[row]; const int pos = row & seqmask;
          u32x4 w;
#pragma unroll
          for (int n = 0; n < 2; ++n) {
            pg8::f32x4 v = acc[ai][bj][m][n] * rs;
            if (kind == 0) { v[0] = gelu_t(v[0]); v[1] = gelu_t(v[1]); v[2] = gelu_t(v[2]); v[3] = gelu_t(v[3]); }
            else if (kind == 4) { v[0] = sigm(v[0]); v[1] = sigm(v[1]); v[2] = sigm(v[2]); v[3] = sigm(v[3]); }
            else if (kind == 3 || kind == 2) {
              const pg8::f32x4 cs = kind == 3 ? *(const pg8::f32x4*)(R128 + pos * 64 + ((((c0 + 4 * n) - C_Q) & 127) >> 1))
                                              : *(const pg8::f32x4*)(R64 + pos * 32 + (((c0 + 4 * n) - C_KR) >> 1));
              const float a0 = v[0] * cs[0] - v[1] * cs[1], a1 = v[1] * cs[0] + v[0] * cs[1], a2 = v[2] * cs[2] - v[3] * cs[3], a3 = v[3] * cs[2] + v[2] * cs[3];
              v[0] = a0; v[1] = a1; v[2] = a2; v[3] = a3;
            }
            w[2 * n] = cvtpk(v[0], v[1]); w[2 * n + 1] = cvtpk(v[2], v[3]);
          }
          if (kind == 2) {
#pragma unroll
            for (int h = 0; h < 8; ++h) *(u32x4*)(KM + (size_t)row * 1536 + h * 192 + 128 + (c0 - C_KR)) = w;
          } else *(u32x4*)(PROJ + (size_t)row * INP + c0) = w;
        }
    }
  }
};

template <int STEP> struct EpiGate {
  static constexpr bool PERM = false, AFTER_DRAIN = false;
  const bf16_t* G; float* MACC; bf16_t* OUT;
  __device__ __forceinline__ void operator()(const pg8::f32x4 (&acc)[2][2][4][2], const pg8::Unit& u, int wr, int wc, int fr, int fq) const {
#pragma unroll
    for (int ai = 0; ai < 2; ++ai)
#pragma unroll
      for (int m = 0; m < 4; ++m) {
        const int row = u.pm * 256 + ai * 128 + wr * 64 + m * 16 + fr; const int c0 = u.pn * 256 + wc * 32 + 4 * fq;
#pragma unroll
        for (int bj = 0; bj < 2; ++bj)
#pragma unroll
          for (int n = 0; n < 2; ++n) {
            const int c = c0 + bj * 128 + n * 16;
            const u32x2 gw = *(const u32x2*)(G + (size_t)row * INP + c);
            pg8::f32x4 v = acc[ai][bj][m][n];
            v[0] *= bflo(gw[0]); v[1] *= bfhi(gw[0]); v[2] *= bflo(gw[1]); v[3] *= bfhi(gw[1]);
            float* mp = MACC + (size_t)row * 1024 + c;
            if (STEP > 0) v += *(const pg8::f32x4*)mp;
            if (STEP < 2) *(pg8::f32x4*)mp = v;
            else { u32x2 w; w[0] = cvtpk(v[0], v[1]); w[1] = cvtpk(v[2], v[3]); *(u32x2*)(OUT + (size_t)row * 1024 + c) = w; }
          }
      }
  }
};

#define LAS __attribute__((address_space(3)))
#define XB_TMO      128
#define XB_XCNT(j)  (256  + 64 * (j))
#define XB_XSUB(j)  (1280 + 64 * (j))
#define XB_XGEN(j)  (2304 + 64 * (j))
#define XB_TOP      3328
#define XB_TOPGEN   3392
#define XCD_BAR_WORDS 3456
#define XB_SPIN_CAP (1u << 22)

__device__ __forceinline__ unsigned xb_ld(unsigned* p)              { return __hip_atomic_load(p, __ATOMIC_RELAXED, __HIP_MEMORY_SCOPE_AGENT); }
__device__ __forceinline__ unsigned xb_add(unsigned* p, unsigned v) { return __hip_atomic_fetch_add(p, v, __ATOMIC_RELAXED, __HIP_MEMORY_SCOPE_AGENT); }
__device__ __forceinline__ unsigned xb_xcc_id() { return (unsigned)__builtin_amdgcn_s_getreg((3 << 11) | 20) & 0xFu; }
#define XB_SPIN(cond, bar) do { unsigned _sp = 0; while (cond) { __builtin_amdgcn_s_sleep(1); \
    if ((++_sp & 255u) == 0u) { if (xb_ld(&(bar)[XB_TMO])) break; if (_sp > XB_SPIN_CAP) { atomicAdd(&(bar)[XB_TMO], 1u); break; } } } } while (0)

struct XcdBarrier {
    unsigned* bar; unsigned x;
    volatile LAS unsigned* st;
};

__device__ __forceinline__ XcdBarrier xcd_barrier_post(unsigned* bar, volatile LAS unsigned* st) {
    XcdBarrier b; b.bar = bar; b.x = xb_xcc_id(); b.st = st;
    if (threadIdx.x == 0) (void)xb_add(&bar[XB_XCNT(b.x)], 1u);
    return b;
}
__device__ __forceinline__ void xcd_barrier_complete(unsigned* bar, unsigned x, unsigned& nloc, unsigned& nx) {
    const unsigned G = gridDim.x * gridDim.y * gridDim.z;
    unsigned sum, cnt, mine, sp = 0u;
    for (;;) {
        sum = 0u; cnt = 0u; mine = 0u;
#pragma unroll
        for (unsigned j = 0; j < 16; ++j) { const unsigned c = xb_ld(&bar[XB_XCNT(j)]); sum += c; cnt += (c > 0u) ? 1u : 0u; mine = (j == x) ? c : mine; }
        if (sum == G) break;
        __builtin_amdgcn_s_sleep(1);
        if ((++sp & 255u) == 0u) { if (xb_ld(&bar[XB_TMO])) break; if (sp > XB_SPIN_CAP) { atomicAdd(&bar[XB_TMO], 1u); break; } }
    }
    nloc = mine > 0u ? mine : 1u; nx = cnt > 0u ? cnt : 1u;
}

__device__ __forceinline__ void xcd_barrier(const XcdBarrier& b) {
    asm volatile("s_waitcnt vmcnt(0)" ::: "memory");
    __syncthreads();
    if (threadIdx.x == 0) {
        unsigned* bar = b.bar;
        __builtin_amdgcn_s_waitcnt(0);
        unsigned nloc = b.st[0], nx = b.st[1];
        if (nloc == 0u) { xcd_barrier_complete(bar, b.x, nloc, nx); b.st[0] = nloc; b.st[1] = nx; }
        const unsigned old = xb_add(&bar[XB_XSUB(b.x)], 1u);
        const unsigned gen = old / nloc;
        if (old + 1u == (gen + 1u) * nloc) {
            __builtin_amdgcn_fence(__ATOMIC_RELEASE, "agent");
            asm volatile("s_waitcnt vmcnt(0)" ::: "memory");
            const unsigned og = xb_add(&bar[XB_TOP], 1u);
            const unsigned tg = og / nx;
            if (og + 1u == (tg + 1u) * nx) xb_add(&bar[XB_TOPGEN], 1u);
            else XB_SPIN(xb_ld(&bar[XB_TOPGEN]) == tg, bar);
            __builtin_amdgcn_fence(__ATOMIC_ACQUIRE, "agent");
            xb_add(&bar[XB_XGEN(b.x)], 1u);
            asm volatile("s_waitcnt vmcnt(0)" ::: "memory");
        } else {
            XB_SPIN(xb_ld(&bar[XB_XGEN(b.x)]) == gen, bar);
            __builtin_amdgcn_fence(__ATOMIC_ACQUIRE, "agent");
            asm volatile("s_waitcnt vmcnt(0)" ::: "memory");
        }
    }
    __syncthreads();
}


DEV void tile_map(int u, int nM, int nN, int& pm, int& pn) {
  const int x = u & 7, t = u >> 3, ML = nM >> 3, per = 4 * nN;
  const int band = t / per, idx = t - band * per;
  pm = x * ML + band * 4 + (idx & 3); pn = idx >> 2;
}

#define TIDX() const int tid = ltid(), lane = tid & 63, wid = tid >> 6, r32 = lane & 31, hi = lane >> 5, wm = wid & 3, wn = wid >> 2; (void)lane; (void)wid; (void)r32; (void)hi; (void)wm; (void)wn
#define GTID() const int gtid = bid * NTHR + ltid(), gsz = nblk * NTHR
DEV void run_phase(const Params& p, const int grp, const int l, const int ph, char* lds) {
  const int nblk = gridDim.x, bid = blockIdx.x;
  char* ws = p.ws;
  float2* R128 = (float2*)(ws + O_R128); float2* R64 = (float2*)(ws + O_R64); float* RS1 = (float*)(ws + O_RS1); float* RS2 = (float*)(ws + O_RS2);
  bf16_t* HN = (bf16_t*)(ws + O_HN); bf16_t* PROJ = (bf16_t*)(ws + O_PROJ); bf16_t* QM = (bf16_t*)(ws + O_QM); bf16_t* KM = (bf16_t*)(ws + O_KM);
  bf16_t* VM = (bf16_t*)(ws + O_VM); bf16_t* YB = (bf16_t*)(ws + O_YB);
  bf16_t* MERGED = (bf16_t*)(ws + O_MERGED); bf16_t* MIX = (bf16_t*)(ws + O_MIX); bf16_t* H2 = (bf16_t*)(ws + O_H2); bf16_t* TT = (bf16_t*)(ws + O_TT); bf16_t* FF = (bf16_t*)(ws + O_FF);

  const int T = grp < 2 ? 32768 : 16384, seqlen = grp < 2 ? 8192 : 4096, nseq = 4;
  const float* xin0 = grp < 2 ? p.in[0] + (size_t)grp * 32768 * 1024 : p.in[1];
  float* xout = p.out + (size_t)(grp < 2 ? grp * 32768 : 65536) * 1024;
  const char* wl = ws + (size_t)l * WL;
  const float* xres = l == 0 ? xin0 : xout;
  if (ph == 0) {
  { GTID();
  for (int l = 0; l < 2; ++l) {
    char* wl = ws + (size_t)l * WL;
    prep_w<MAP_IN>((bf16_t*)(wl + O_WIN), INP, 1024, p.in[3] + (size_t)l * 1024 * 7360, nullptr, 7360, p.in[2] + l * 1024, gtid, gsz);
    prep_w<MAP_UQ>((bf16_t*)(wl + O_WUQ), 1536, 384, p.in[9] + (size_t)l * 384 * 1536, nullptr, 1536, p.in[8] + l * 384, gtid, gsz);
    prep_w<MAP_ID>((bf16_t*)(wl + O_WUKV), 2048, 256, p.in[11] + (size_t)l * 256 * 2048, nullptr, 2048, p.in[10] + l * 256, gtid, gsz);
    prep_w<MAP_ID>((bf16_t*)(wl + O_WPA), 1024, 1024, p.in[13] + (size_t)l * 1024 * 1024, nullptr, 1024, nullptr, gtid, gsz);
    prep_w<MAP_ID>((bf16_t*)(wl + O_WPB), 1024, 1024, p.in[14] + (size_t)l * 1024 * 1024, nullptr, 1024, nullptr, gtid, gsz);
    prep_w<MAP_ID>((bf16_t*)(wl + O_WPC), 1024, 1024, p.in[15] + (size_t)l * 1024 * 1024, nullptr, 1024, nullptr, gtid, gsz);
    prep_w<MAP_ID>((bf16_t*)(wl + O_WO), 1024, 1024, p.in[16] + (size_t)l * 1024 * 1024, nullptr, 1024, nullptr, gtid, gsz);
    prep_w<MAP_GU>((bf16_t*)(wl + O_WGU), 5632, 1024, p.in[19] + (size_t)l * 1024 * DFF, p.in[20] + (size_t)l * 1024 * DFF, DFF, p.in[18] + l * 1024, gtid, gsz);
    prep_w<MAP_ID>((bf16_t*)(wl + O_WD), 1024, DFF, p.in[21] + (size_t)l * DFF * 1024, nullptr, 1024, nullptr, gtid, gsz);
    { bf16_t* d = (bf16_t*)(wl + O_WS); const float* s = p.in[6] + (size_t)l * 8 * 128 * 128; for (int i = gtid; i < 8 * 128 * 128; i += gsz) d[i] = f2bf(s[i]); }
  }
  for (int i = gtid; i < 8192 * 64; i += gsz) { const int pos = i >> 6, f = i & 63; double rev = (double)pos * RPP128[f]; rev -= floor(rev); const float fr = (float)rev;
    R128[i] = make_float2(__builtin_amdgcn_cosf(fr), __builtin_amdgcn_sinf(fr)); }
  for (int i = gtid; i < 8192 * 32; i += gsz) { const int pos = i >> 5, f = i & 31; double rev = (double)pos * RPP64[f]; rev -= floor(rev); const float fr = (float)rev;
    R64[i] = make_float2(__builtin_amdgcn_cosf(fr), __builtin_amdgcn_sinf(fr)); }
  }
  }
  if (ph == 0) { TIDX(); phase_cvt(p.in[0], HN, RS1, 32768, bid * 8 + wid, nblk * 8, lane); }
      if (ph == 2) {
        pg8::Gemm g{HN, (const bf16_t*)(wl + O_WIN), T, INP, 1024};
        pg8::StaticOrder so; so.init(T, INP, nblk, bid);
        EpiIn e{PROJ, KM, R64, R128, RS1, seqlen - 1};
        pg8::gemm_phase<EpiIn, pg8::StaticOrder, true, true>((PG8_LAS unsigned char*)lds, g, so, e);
      }
      if (ph == 3) {
        const int nG = T / 128, nQ = (T / 256) * 6, nKV = (T / 256) * 8, nU = nG + nQ + nKV;
        for (int u = bid; u < nU; u += nblk) {
          if (u < nG) {
#ifndef NO_GMLP
            gmlp_unit(u, PROJ, (const bf16_t*)(wl + O_WS), p.in[4] + l * 1024, p.in[5] + l * 1024, p.in[7] + l * 1024, lds);
#endif
          } else if (u < nG + nQ) {
            const int v_ = u - nG, nM = T / 256; const int m0 = (v_ % nM) * 256, n0 = (v_ / nM) * 256;
            f32x16 acc[2][4]; float ss[2];
            gemm_mainloop<2, true>(acc, ss, PROJ + (size_t)m0 * INP + C_CQL, INP, (const bf16_t*)(wl + O_WUQ) + (size_t)n0 * 384, 384, 384, lds);
            rowss_finish<2>(ss, 384, lds);
            TIDX();
            const float* rs_l = (const float*)(lds + GemmCfg<2>::RS_OFF);
#pragma unroll
            for (int mi = 0; mi < 2; ++mi) {
              const int rbl = wm * 64 + mi * 32;
#pragma unroll
              for (int nf = 0; nf < 4; ++nf) {
                const int cb = n0 + wn * 128 + nf * 32, col = cb + r32; const int jb = cb % 192;
#pragma unroll
                for (int r = 0; r < 16; ++r) {
                  const int rl = rbl + crow(r, hi); const unsigned row = (unsigned)(m0 + rl);
                  float v = acc[mi][nf][r] * rs_l[rl];
                  if (jb >= 128) {
                    const float pr = __shfl_xor(v, 1); const int j = (jb - 128) + r32; const int pos = (int)row & (seqlen - 1);
                    const float2 cs = R64[pos * 32 + (j >> 1)];
                    v = (j & 1) ? (v * cs.x + pr * cs.y) : (v * cs.x - pr * cs.y);
                  }
                  QM[row * 1536 + col] = f2bf(v);
                }
              }
            }
          } else {
            const int v_ = u - nG - nQ, nM = T / 256; const int m0 = (v_ % nM) * 256, n0 = (v_ / nM) * 256;
            f32x16 acc[2][4]; float ss[2];
            gemm_mainloop<2, true>(acc, ss, PROJ + (size_t)m0 * INP + C_CKV, INP, (const bf16_t*)(wl + O_WUKV) + (size_t)n0 * 256, 256, 256, lds);
            rowss_finish<2>(ss, 256, lds);
            TIDX();
            const float* rs_l = (const float*)(lds + GemmCfg<2>::RS_OFF);
            const int h = n0 >> 8;
#pragma unroll
            for (int mi = 0; mi < 2; ++mi) {
              const int rbl = wm * 64 + mi * 32;
#pragma unroll
              for (int nf = 0; nf < 4; ++nf) {
                const int j = nf * 32 + r32;
#pragma unroll
                for (int r = 0; r < 16; ++r) {
                  const int rl = rbl + crow(r, hi); const unsigned row = (unsigned)(m0 + rl);
                  const bf16_t ob = f2bf(acc[mi][nf][r] * rs_l[rl]);
                  if (wn == 0) KM[row * 1536 + h * 192 + j] = ob; else VM[row * 1024 + h * 128 + j] = ob;
                }
              }
            }
          }
        }
      }
      if (ph == 4) {
        const int nqb = seqlen / 256, nU = nseq * 8 * nqb;
        for (int u = bid; u < nU; u += nblk) {
          const int b = u & 255, i = u >> 8; const int y = b >> 3; const int qb = y % nqb, sub = y / nqb;
          const int sh = (b & 7) + 8 * (i * (32 / nqb) + sub); const int s = sh >> 3, h = sh & 7;
          const size_t tq = (size_t)s * seqlen + (size_t)qb * 256, tk = (size_t)s * seqlen;
#ifndef NO_MLA
          attn_unit<192, false, false>(QM + tq * 1536 + h * 192, 1536, KM + tk * 1536 + h * 192, 1536, VM + tk * 1024 + h * 128, 1024,
                                YB + tq * 1024 + h * 128, 1024, 0, seqlen / 64, qb * 256, 0.f, 0.07216878364870322f, lds);
#else
          { const int t_ = ltid(); for (int e = t_; e < 256 * 128; e += NTHR) YB[(tq + (e >> 7)) * 1024 + h * 128 + (e & 127)] = 0; (void)tk; }
#endif
        }
        const float* sinkp = p.in[12] + l * 8;
        for (int u = bid; u < nU; u += nblk) {
          const int b = u & 255, i = u >> 8; const int y = b >> 3; const int qb = y % nqb, sub = y / nqb;
          const int sh = (b & 7) + 8 * (i * (32 / nqb) + sub); const int s = sh >> 3, h = sh & 7, kvh = h >> 2;
          const size_t tq = (size_t)s * seqlen + (size_t)qb * 256, tk = (size_t)s * seqlen;
          const int q0 = qb * 256; const int kb0 = q0 - 128 < 0 ? 0 : q0 - 128; const int ke = q0 + 384 > seqlen ? seqlen : q0 + 384;
#ifndef NO_GQA
          attn_unit<128, true, true>(PROJ + tq * INP + C_Q + h * 128, INP, PROJ + tk * INP + C_K + kvh * 128, INP, PROJ + tk * INP + C_VV + kvh * 128, INP,
                               PROJ + tq * INP + C_Q + h * 128, INP, kb0, (ke - kb0) / 64, q0, sinkp[h], 0.08838834764831845f, lds);
#else
          { const int t_ = ltid(); for (int e = t_; e < 256 * 128; e += NTHR) PROJ[(tq + (e >> 7)) * INP + C_Q + h * 128 + (e & 127)] = 0; (void)tk; (void)kvh; (void)kb0; (void)ke; (void)sinkp; }
#endif
        }
      }
      if (ph == 5) {
        float* MACC = (float*)(ws + O_QM);
        pg8::StaticOrder so; so.init(T, 1024, nblk, bid);
        { pg8::Gemm g{PROJ + C_U, (const bf16_t*)(wl + O_WPA), T, 1024, 1024}; EpiGate<0> e{PROJ + C_G, MACC, MERGED};
          pg8::gemm_phase<EpiGate<0>, pg8::StaticOrder, true, true>((PG8_LAS unsigned char*)lds, g, so, e, INP); }
        { pg8::Gemm g{YB, (const bf16_t*)(wl + O_WPB), T, 1024, 1024}; EpiGate<1> e{PROJ + C_G + 1024, MACC, MERGED};
          pg8::gemm_phase<EpiGate<1>, pg8::StaticOrder, true, true>((PG8_LAS unsigned char*)lds, g, so, e, 1024); }
        { pg8::Gemm g{PROJ + C_Q, (const bf16_t*)(wl + O_WPC), T, 1024, 1024}; EpiGate<2> e{PROJ + C_G + 2048, MACC, MERGED};
          pg8::gemm_phase<EpiGate<2>, pg8::StaticOrder, true, true>((PG8_LAS unsigned char*)lds, g, so, e, INP); }
      }
      if (ph == 6) {
        pg8::Gemm g{MERGED, (const bf16_t*)(wl + O_WO), T, 1024, 1024};
        pg8::StaticOrder so; so.init(T, 1024, nblk, bid);
        EpiF32 e{MIX};
        pg8::gemm_phase<EpiF32, pg8::StaticOrder, true, true>((PG8_LAS unsigned char*)lds, g, so, e);
      }
      if (ph == 7) { TIDX(); phase_resnorm(MIX, xres, p.in[17] + l * 1024, xout, H2, RS2, T, bid * 8 + wid, nblk * 8, lane); }
      if (ph == 8) {
        pg8::Gemm g{H2, (const bf16_t*)(wl + O_WGU), T, 5632, 1024};
        pg8::StaticOrder so; so.init(T, 5632, nblk, bid);
        EpiSwiGLU e{TT, RS2};
        pg8::gemm_phase<EpiSwiGLU, pg8::StaticOrder, true, true>((PG8_LAS unsigned char*)lds, g, so, e);
      }
      if (ph == 9) {
        pg8::Gemm g{TT, (const bf16_t*)(wl + O_WD), T, 1024, DFF};
        pg8::StaticOrder so; so.init(T, 1024, nblk, bid);
        EpiF32 e{FF};
        pg8::gemm_phase<EpiF32, pg8::StaticOrder, true, true>((PG8_LAS unsigned char*)lds, g, so, e);
      }
      if (ph == 10) { TIDX(); phase_resnorm(FF, xout, p.in[22] + l * 1024, xout, l == 0 ? HN : nullptr, l == 0 ? RS1 : nullptr, T, bid * 8 + wid, nblk * 8, lane);
        if (l == 1 && grp < 2) phase_cvt(grp == 0 ? p.in[0] + (size_t)32768 * 1024 : p.in[1], HN, RS1, grp == 0 ? 32768 : 16384, bid * 8 + wid, nblk * 8, lane); }
}

#define GSYNC() xcd_barrier(xb)
__global__ void __launch_bounds__(NTHR) mega(Params p) {
  extern __shared__ __attribute__((aligned(16))) char lds[];
  cg::grid_group grid = cg::this_grid();
  volatile LAS unsigned* bst = (volatile LAS unsigned*)(lds + 151552);
  if (threadIdx.x == 0) { bst[0] = 0u; bst[1] = 0u; }
  __syncthreads();
  const XcdBarrier xb = xcd_barrier_post((unsigned*)(p.ws + O_BAR), bst);
  grid.sync();
  run_phase(p, 0, 0, 0, lds);
  GSYNC();
  for (int grp = 0; grp < 3; ++grp) {
    for (int l = 0; l < 2; ++l)
      for (int ph = 2; ph <= 10; ++ph) { run_phase(p, grp, l, ph, lds); GSYNC(); }
  }
}
__global__ void __launch_bounds__(NTHR) phase_k(Params p, int grp, int l, int ph) {
  extern __shared__ __attribute__((aligned(16))) char lds[];
  run_phase(p, grp, l, ph, lds);
}

extern "C" void kernel_launch(void* const* d_in, const int* in_sizes, int n_in, void* d_out, int out_size, void* d_ws, size_t ws_size, hipStream_t stream) {
  static int grid_blocks = 0;
  if (!grid_blocks) {
    if (ws_size < WS_END) { fprintf(stderr, "kernel_launch: ws too small %zu < %zu\n", ws_size, (size_t)WS_END); return; }
    (void)hipFuncSetAttribute((const void*)mega, hipFuncAttributeMaxDynamicSharedMemorySize, LDS_BYTES);
    (void)hipFuncSetAttribute((const void*)phase_k, hipFuncAttributeMaxDynamicSharedMemorySize, LDS_BYTES);
    int dev = 0, cus = 0, per_cu = 0;
    hipGetDevice(&dev);
    hipDeviceGetAttribute(&cus, hipDeviceAttributeMultiprocessorCount, dev);
    hipOccupancyMaxActiveBlocksPerMultiprocessor(&per_cu, mega, NTHR, LDS_BYTES);
    if (per_cu < 1) per_cu = 1;
    grid_blocks = cus;
    if (grid_blocks > 256) grid_blocks = 256;
  }
  Params p;
  memset(&p, 0, sizeof(p));
  for (int i = 0; i < 23; ++i) p.in[i] = (const float*)d_in[i];
  p.out = (float*)d_out; p.ws = (char*)d_ws;
  (void)hipMemsetAsync((char*)d_ws + O_BAR, 0, 16384, stream);
#ifdef MULTI_LAUNCH
  auto launch = [&](int grp, int l, int ph) { hipLaunchKernelGGL(phase_k, dim3(grid_blocks), dim3(NTHR), LDS_BYTES, stream, p, grp, l, ph); };
  launch(0, 0, 0);
  for (int grp = 0; grp < 3; ++grp) { for (int l = 0; l < 2; ++l) for (int ph = 2; ph <= 10; ++ph) launch(grp, l, ph); }
#else
  void* args[] = {&p};
  hipError_t e = hipLaunchCooperativeKernel((void*)mega, dim3(grid_blocks), dim3(NTHR), args, LDS_BYTES, stream);
  if (e != hipSuccess) fprintf(stderr, "cooperative launch failed: %s (grid %d)\n", hipGetErrorString(e), grid_blocks);
#endif
}
```

```cpp
#include <hip/hip_runtime.h>
#include <hip/hip_cooperative_groups.h>
#include <cstdio>
#include <cmath>
#include <cstdint>
#include <cstring>
namespace cg = cooperative_groups;

#define DEV __device__ __forceinline__
typedef unsigned short bf16_t;
typedef short bf16x8 __attribute__((ext_vector_type(8)));
typedef short s16x4 __attribute__((ext_vector_type(4)));
typedef float f32x16 __attribute__((ext_vector_type(16)));
typedef float f32x4 __attribute__((ext_vector_type(4)));
typedef unsigned u32x4 __attribute__((ext_vector_type(4)));
typedef unsigned u32x2 __attribute__((ext_vector_type(2)));

constexpr int DM = 1024, INP = 7424, DFF = 2816, TG = 32768, NTHR = 512;
constexpr int C_U = 0, C_V = 1024, C_CQL = 2048, C_CKV = 2432, C_KR = 2688, C_Q = 2752, C_K = 3776, C_VV = 4032, C_G = 4288, C_END = 7360;
constexpr float EPS = 1e-6f;
constexpr size_t SZ_WIN = (size_t)INP * 1024 * 2, SZ_WUQ = (size_t)1536 * 384 * 2, SZ_WUKV = (size_t)2048 * 256 * 2, SZ_SQ = (size_t)1024 * 1024 * 2,
                 SZ_WGU = (size_t)5632 * 1024 * 2, SZ_WD = (size_t)1024 * DFF * 2, SZ_WS = (size_t)8 * 128 * 128 * 2;
constexpr size_t O_WIN = 0, O_WUQ = O_WIN + SZ_WIN, O_WUKV = O_WUQ + SZ_WUQ, O_WPA = O_WUKV + SZ_WUKV, O_WPB = O_WPA + SZ_SQ, O_WPC = O_WPB + SZ_SQ,
                 O_WO = O_WPC + SZ_SQ, O_WGU = O_WO + SZ_SQ, O_WD = O_WGU + SZ_WGU, O_WS = O_WD + SZ_WD, WL = O_WS + SZ_WS;
constexpr size_t O_R128 = 2 * WL, O_R64 = O_R128 + (size_t)8192 * 64 * 8, O_BAR = O_R64 + (size_t)8192 * 32 * 8, O_RS1 = O_BAR + 16384,
                  O_RS2 = O_RS1 + (size_t)TG * 4, O_ACT = O_RS2 + (size_t)TG * 4;
constexpr size_t O_HN = O_ACT, O_PROJ = O_HN + (size_t)TG * 1024 * 2, O_QM = O_PROJ + (size_t)TG * INP * 2, O_KM = O_QM + (size_t)TG * 1536 * 2,
                 O_VM = O_KM + (size_t)TG * 1536 * 2, O_YB = O_VM + (size_t)TG * 1024 * 2, WS_END = O_YB + (size_t)TG * 1024 * 2;
constexpr size_t O_MERGED = O_HN, O_MIX = O_QM, O_H2 = O_VM, O_TT = O_PROJ, O_FF = O_QM;
constexpr int LDS_BYTES = 151552 + 64;
#ifndef PH_MASK
#define PH_MASK 0xFFFF
#endif
#define PH(k) constexpr ((PH_MASK >> (k)) & 1)

struct Params {
  const float* in[23];
  float* out;
  char* ws;
};
__constant__ double RPP128[64] = {0.15915494309189535, 0.13782250260398285, 0.11934937021124886, 0.10335229661843406, 0.08949940160889101, 0.07750328875537404, 0.06711508300522726, 0.05811926744187624, 0.050329212104487035, 0.04358330210530733, 0.03774158471741978, 0.032682865872357, 0.028302195830623395, 0.024508691862069852, 0.02122365276477766, 0.018378926105679667, 0.015915494309189534, 0.013782250260398287, 0.011934937021124886, 0.010335229661843406, 0.0089499401608891, 0.0077503288755374055, 0.006711508300522725, 0.005811926744187624, 0.005032921210448704, 0.004358330210530732, 0.0037741584717419768, 0.0032682865872357, 0.00283021958306234, 0.002450869186206985, 0.0021223652764777662, 0.0018378926105679669, 0.0015915494309189536, 0.0013782250260398283, 0.0011934937021124887, 0.0010335229661843407, 0.0008949940160889102, 0.0007750328875537407, 0.0006711508300522726, 0.0005811926744187624, 0.0005032921210448703, 0.0004358330210530733, 0.0003774158471741977, 0.0003268286587235699, 0.000283021958306234, 0.0002450869186206985, 0.0002122365276477766, 0.00018378926105679666, 0.00015915494309189535, 0.00013782250260398286, 0.00011934937021124885, 0.00010335229661843405, 8.949940160889102e-05, 7.750328875537406e-05, 6.711508300522727e-05, 5.811926744187624e-05, 5.0329212104487035e-05, 4.358330210530733e-05, 3.774158471741978e-05, 3.2682865872357e-05, 2.8302195830623396e-05, 2.4508691862069852e-05, 2.122365276477766e-05, 1.8378926105679668e-05};
__constant__ double RPP64[32] = {0.15915494309189535, 0.11934937021124886, 0.08949940160889101, 0.06711508300522726, 0.050329212104487035, 0.03774158471741978, 0.028302195830623395, 0.02122365276477766, 0.015915494309189534, 0.011934937021124886, 0.0089499401608891, 0.006711508300522725, 0.005032921210448704, 0.0037741584717419768, 0.00283021958306234, 0.0021223652764777662, 0.0015915494309189536, 0.0011934937021124887, 0.0008949940160889102, 0.0006711508300522726, 0.0005032921210448703, 0.0003774158471741977, 0.000283021958306234, 0.0002122365276477766, 0.00015915494309189535, 0.00011934937021124885, 8.949940160889102e-05, 6.711508300522727e-05, 5.0329212104487035e-05, 3.774158471741978e-05, 2.8302195830623396e-05, 2.122365276477766e-05};
DEV int ltid() { int t = threadIdx.x; asm volatile("" : "+v"(t)); return t; }

typedef __bf16 bf16x2_t __attribute__((ext_vector_type(2)));
typedef float f32x2 __attribute__((ext_vector_type(2)));
DEV unsigned cvtpk(float lo, float hi) { f32x2 v = {lo, hi}; bf16x2_t b = __builtin_convertvector(v, bf16x2_t); return __builtin_bit_cast(unsigned, b); }
DEV bf16_t f2bf(float x) { return (bf16_t)(cvtpk(x, 0.f) & 0xffffu); }
DEV float bf2f(bf16_t u) { return __uint_as_float(((unsigned)u) << 16); }
DEV float bflo(unsigned w) { return __uint_as_float(w << 16); }
DEV float bfhi(unsigned w) { return __uint_as_float(w & 0xffff0000u); }
DEV int crow(int r, int hi) { return (r & 3) + 8 * (r >> 2) + 4 * hi; }
DEV float gelu_t(float x) { float z = 0.7978845608f * (x + 0.044715f * x * x * x); return x * __builtin_amdgcn_rcpf(1.f + __expf(-2.f * z)); }
DEV float sigm(float x) { return __builtin_amdgcn_rcpf(1.f + __expf(-x)); }
#define SBAR() __builtin_amdgcn_sched_barrier(0)

constexpr int G_ROWB = 144;
template <int MI> struct GemmCfg { static constexpr int TM = 128 * MI, AB = TM * G_ROWB, BB = 256 * G_ROWB, STAGE = AB + BB, RS_OFF = 2 * STAGE; };

template <int MI, bool ROWSS>
DEV void gemm_mainloop(f32x16 (&acc)[MI][4], float (&ss)[MI], const bf16_t* __restrict__ A, int lda, const bf16_t* __restrict__ Bt, int ldb, int K, char* lds) {
  using C = GemmCfg<MI>;
  const int tid = ltid(), lane = tid & 63, wid = tid >> 6, r32 = lane & 31, hi = lane >> 5, wm = wid & 3, wn = wid >> 2;
  u32x4 ra[2 * MI], rb[4];
  const int prow = tid >> 3, pkc = (tid & 7) * 8;
  const bf16_t* ga = A + (size_t)prow * lda + pkc;
  const bf16_t* gb = Bt + (size_t)prow * ldb + pkc;
  const int lw = prow * G_ROWB + pkc * 2;
  const int aoff = (wm * 32 * MI + r32) * G_ROWB + hi * 16;
  const int boff = C::AB + (wn * 128 + r32) * G_ROWB + hi * 16;
#pragma unroll
  for (int mi = 0; mi < MI; ++mi) {
    ss[mi] = 0.f;
#pragma unroll
    for (int nf = 0; nf < 4; ++nf)
#pragma unroll
      for (int r = 0; r < 16; ++r) acc[mi][nf][r] = 0.f;
  }
  const int nk = K >> 6;
#define G_LOAD(kt_) do { const int k0_ = (kt_) << 6; \
    _Pragma("unroll") for (int i = 0; i < 2 * MI; ++i) ra[i] = *(const u32x4*)(ga + (size_t)i * 64 * lda + k0_); \
    _Pragma("unroll") for (int i = 0; i < 4; ++i) rb[i] = *(const u32x4*)(gb + (size_t)i * 64 * ldb + k0_); } while (0)
#define G_WRITE(s_) do { char* wb_ = lds + (s_) * C::STAGE; \
    _Pragma("unroll") for (int i = 0; i < 2 * MI; ++i) *(u32x4*)(wb_ + lw + i * 64 * G_ROWB) = ra[i]; \
    _Pragma("unroll") for (int i = 0; i < 4; ++i) *(u32x4*)(wb_ + C::AB + lw + i * 64 * G_ROWB) = rb[i]; } while (0)
  G_LOAD(0); G_WRITE(0); G_LOAD(1);
  __syncthreads();
  for (int kt = 0; kt < nk; ++kt) {
    const char* base = lds + (kt & 1) * C::STAGE;
    SBAR();
#pragma unroll
    for (int ks = 0; ks < 4; ++ks) {
      bf16x8 a[MI], b[4];
#pragma unroll
      for (int mi = 0; mi < MI; ++mi) a[mi] = *(const bf16x8*)(base + aoff + mi * 32 * G_ROWB + ks * 32);
#pragma unroll
      for (int nf = 0; nf < 4; ++nf) b[nf] = *(const bf16x8*)(base + boff + nf * 32 * G_ROWB + ks * 32);
      if (ROWSS) {
#pragma unroll
        for (int mi = 0; mi < MI; ++mi)
#pragma unroll
          for (int j = 0; j < 8; ++j) { float f = bf2f((bf16_t)a[mi][j]); ss[mi] += f * f; }
      }
      __builtin_amdgcn_s_setprio(1);
#pragma unroll
      for (int mi = 0; mi < MI; ++mi)
#pragma unroll
        for (int nf = 0; nf < 4; ++nf) acc[mi][nf] = __builtin_amdgcn_mfma_f32_32x32x16_bf16(a[mi], b[nf], acc[mi][nf], 0, 0, 0);
      __builtin_amdgcn_s_setprio(0);
    }
    SBAR();
    if (kt + 1 < nk) { G_WRITE((kt + 1) & 1); if (kt + 2 < nk) G_LOAD(kt + 2); }
    __syncthreads();
  }
#undef G_LOAD
#undef G_WRITE
}

template <int MI>
DEV void rowss_finish(float (&ss)[MI], int K, char* lds) {
  using C = GemmCfg<MI>;
  const int tid = ltid(), lane = tid & 63, wid = tid >> 6, r32 = lane & 31, hi = lane >> 5, wm = wid & 3, wn = wid >> 2;
  float* rs_l = (float*)(lds + C::RS_OFF);
#pragma unroll
  for (int mi = 0; mi < MI; ++mi) {
    float t = ss[mi] + __shfl_xor(ss[mi], 32);
    if (wn == 0 && hi == 0) rs_l[wm * 32 * MI + mi * 32 + r32] = rsqrtf(t / (float)K + EPS);
  }
  __syncthreads();
}

DEV int v_st(int k, int c) { const int kk = (k & ~0xC) | ((k & 4) << 1) | ((k & 8) >> 1); return ((kk >> 3) * 4 + (c >> 5)) * 512 + ((kk & 7) * 32 + (c & 31)) * 2; }
DEV int v_rd_base(int lane) { return ((lane & 3) << 3) | (((lane >> 2) & 3) << 6) | (((lane >> 4) & 1) << 5) | (((lane >> 5) & 1) << 8); }
constexpr int v_rd_off(int d0, int ks, int half) { return d0 * 512 + ks * 4096 + half * 2048; }
template <int OFF> DEV s16x4 tr_read(int vb) { s16x4 r; asm volatile("ds_read_b64_tr_b16 %0, %1 offset:%2" : "=&v"(r) : "v"(vb), "i"(OFF) : "memory"); return r; }
template <int D0, bool SPLIT = true> DEV void pv_one(f32x16& od, int vb, bf16x8 pa0, bf16x8 pa1, bf16x8 pa2, bf16x8 pa3) {
#define PK(L, H) (bf16x8){L[0], L[1], L[2], L[3], H[0], H[1], H[2], H[3]}
  if constexpr (SPLIT) {
  {
    const s16x4 l0 = tr_read<v_rd_off(D0, 0, 0)>(vb), h0 = tr_read<v_rd_off(D0, 0, 1)>(vb), l1 = tr_read<v_rd_off(D0, 1, 0)>(vb), h1 = tr_read<v_rd_off(D0, 1, 1)>(vb);
    asm volatile("s_waitcnt lgkmcnt(0)" ::: "memory"); SBAR();
    od = __builtin_amdgcn_mfma_f32_32x32x16_bf16(pa0, PK(l0, h0), od, 0, 0, 0);
    od = __builtin_amdgcn_mfma_f32_32x32x16_bf16(pa1, PK(l1, h1), od, 0, 0, 0);
  }
  {
    const s16x4 l2 = tr_read<v_rd_off(D0, 2, 0)>(vb), h2 = tr_read<v_rd_off(D0, 2, 1)>(vb), l3 = tr_read<v_rd_off(D0, 3, 0)>(vb), h3 = tr_read<v_rd_off(D0, 3, 1)>(vb);
    asm volatile("s_waitcnt lgkmcnt(0)" ::: "memory"); SBAR();
    od = __builtin_amdgcn_mfma_f32_32x32x16_bf16(pa2, PK(l2, h2), od, 0, 0, 0);
    od = __builtin_amdgcn_mfma_f32_32x32x16_bf16(pa3, PK(l3, h3), od, 0, 0, 0);
  }
  } else {
    const s16x4 l0 = tr_read<v_rd_off(D0, 0, 0)>(vb), h0 = tr_read<v_rd_off(D0, 0, 1)>(vb), l1 = tr_read<v_rd_off(D0, 1, 0)>(vb), h1 = tr_read<v_rd_off(D0, 1, 1)>(vb);
    const s16x4 l2 = tr_read<v_rd_off(D0, 2, 0)>(vb), h2 = tr_read<v_rd_off(D0, 2, 1)>(vb), l3 = tr_read<v_rd_off(D0, 3, 0)>(vb), h3 = tr_read<v_rd_off(D0, 3, 1)>(vb);
    asm volatile("s_waitcnt lgkmcnt(0)" ::: "memory"); SBAR();
    od = __builtin_amdgcn_mfma_f32_32x32x16_bf16(pa0, PK(l0, h0), od, 0, 0, 0);
    od = __builtin_amdgcn_mfma_f32_32x32x16_bf16(pa1, PK(l1, h1), od, 0, 0, 0);
    od = __builtin_amdgcn_mfma_f32_32x32x16_bf16(pa2, PK(l2, h2), od, 0, 0, 0);
    od = __builtin_amdgcn_mfma_f32_32x32x16_bf16(pa3, PK(l3, h3), od, 0, 0, 0);
  }
#undef PK
}
template <bool SPLIT = true> DEV void pv_d0(f32x16* o, int vb, bf16x8 pa0, bf16x8 pa1, bf16x8 pa2, bf16x8 pa3) {
  pv_one<0, SPLIT>(o[0], vb, pa0, pa1, pa2, pa3); pv_one<1, SPLIT>(o[1], vb, pa0, pa1, pa2, pa3); pv_one<2, SPLIT>(o[2], vb, pa0, pa1, pa2, pa3); pv_one<3, SPLIT>(o[3], vb, pa0, pa1, pa2, pa3);
}

template <bool WIN>
DEV void partialSM(f32x16& p0, f32x16& p1, float& m_reg, float& mn, float& alpha, const float C, const float thr_raw, int kdiff) {
  if (WIN) {
#pragma unroll
    for (int r = 0; r < 16; ++r) {
      const int d = kdiff + (r & 3) + 8 * (r >> 2);
      if (d > 128 || d < -128) p0[r] = -INFINITY;
      if (d + 32 > 128 || d + 32 < -128) p1[r] = -INFINITY;
    }
  }
  float pmax = p0[0];
#pragma unroll
  for (int r = 1; r < 16; ++r) pmax = fmaxf(pmax, p0[r]);
#pragma unroll
  for (int r = 0; r < 16; ++r) pmax = fmaxf(pmax, p1[r]);
  { auto rr = __builtin_amdgcn_permlane32_swap(__float_as_uint(pmax), __float_as_uint(pmax), false, false);
    pmax = fmaxf(__uint_as_float(rr[0]), __uint_as_float(rr[1])); }
  if (__builtin_expect(__all(pmax - m_reg <= thr_raw), 1)) { mn = m_reg; alpha = 1.f; }
  else { mn = fmaxf(m_reg, pmax); alpha = __builtin_amdgcn_exp2f((m_reg - mn) * C); m_reg = mn; }
  const float mnC = -mn * C;
#pragma unroll
  for (int r = 0; r < 16; ++r) p0[r] = fmaf(p0[r], C, mnC);
#pragma unroll
  for (int r = 0; r < 16; ++r) p1[r] = fmaf(p1[r], C, mnC);
#pragma unroll
  for (int r = 0; r < 16; ++r) p0[r] = __builtin_amdgcn_exp2f(p0[r]);
}
DEV void finishSM(f32x16& p0, f32x16& p1, float alpha, float& l_reg, bf16x8& pa0, bf16x8& pa1, bf16x8& pa2, bf16x8& pa3) {
#pragma unroll
  for (int r = 0; r < 16; ++r) p1[r] = __builtin_amdgcn_exp2f(p1[r]);
  float ps = 0;
#pragma unroll
  for (int r = 0; r < 16; ++r) ps += p0[r];
#pragma unroll
  for (int r = 0; r < 16; ++r) ps += p1[r];
  { auto rr = __builtin_amdgcn_permlane32_swap(__float_as_uint(ps), __float_as_uint(ps), false, false);
    ps = __uint_as_float(rr[0]) + __uint_as_float(rr[1]); }
  l_reg = l_reg * alpha + ps;
#define PK4(P, BASE, OUT) do { unsigned a0 = cvtpk(P[BASE + 0], P[BASE + 1]), a1 = cvtpk(P[BASE + 2], P[BASE + 3]);   \
    unsigned b0 = cvtpk(P[BASE + 4], P[BASE + 5]), b1 = cvtpk(P[BASE + 6], P[BASE + 7]);                              \
    auto r0 = __builtin_amdgcn_permlane32_swap(a0, b0, false, false); auto r1 = __builtin_amdgcn_permlane32_swap(a1, b1, false, false); \
    u32x4 w = {r0[0], r1[0], r0[1], r1[1]}; OUT = *reinterpret_cast<bf16x8*>(&w); } while (0)
  PK4(p0, 0, pa0); PK4(p0, 8, pa1); PK4(p1, 0, pa2); PK4(p1, 8, pa3);
#undef PK4
}

template <int DQK> struct ACfg { static constexpr int KROW = DQK * 2 + 16, KT = 64 * KROW, NKP = (64 * (DQK / 8)) / NTHR, PPR = DQK / 8; };

template <int DQK, int NQR>
DEV void qkt(f32x16& p0, f32x16& p1, const char* Ks, const bf16x8* qr, const char* qlds_, int r32, int hi) {
  constexpr int KROW = ACfg<DQK>::KROW;
  unsigned qa = (unsigned)(uintptr_t)qlds_; asm volatile("" : "+v"(qa));
  const __attribute__((address_space(3))) char* qlds = (const __attribute__((address_space(3))) char*)qa;
#pragma unroll
  for (int r = 0; r < 16; ++r) { p0[r] = 0.f; p1[r] = 0.f; }
#pragma unroll
  for (int d0 = 0; d0 < DQK / 16; ++d0) {
    const int cb = (d0 * 16 + hi * 8) * 2;
    bf16x8 b0 = *reinterpret_cast<const bf16x8*>(Ks + r32 * KROW + cb);
    bf16x8 b1 = *reinterpret_cast<const bf16x8*>(Ks + (32 + r32) * KROW + cb);
    bf16x8 q;
    if (d0 < NQR) q = qr[d0 < NQR ? d0 : 0]; else q = *reinterpret_cast<const __attribute__((address_space(3))) bf16x8*>(qlds + (d0 - NQR) * 1024);
    p0 = __builtin_amdgcn_mfma_f32_32x32x16_bf16(b0, q, p0, 0, 0, 0);
    p1 = __builtin_amdgcn_mfma_f32_32x32x16_bf16(b1, q, p1, 0, 0, 0);
    if (NQR < DQK / 16 && (d0 & 3) == 3) SBAR();
  }
}

template <int DQK, bool WIN, bool TWO>
DEV void attn_unit(const bf16_t* Qb, int ldq, const bf16_t* __restrict__ Kh, int ldk, const bf16_t* __restrict__ Vh, int ldv,
                   bf16_t* Ob, int ldo, int kbeg, int NT, int q0, float sink, const float SCALE, char* lds) {
  using CF = ACfg<DQK>;
  constexpr int KROW = CF::KROW, KT = CF::KT, NKP = CF::NKP, PPR = CF::PPR, SHM_V = 16384;
  const float C = SCALE * 1.4426950408889634f, thr_raw = 8.f / SCALE;
  const int tid = ltid(), wid = tid >> 6, lane = tid & 63, r32 = lane & 31, hi = lane >> 5;
  char* V_lds = lds; char* K_lds = lds + 2 * SHM_V;
  float* wsf = (float*)(lds + 2 * SHM_V + 2 * KT) + wid * 64; float* li_l = wsf; float* al_l = wsf + 32;
  float m_reg = -1e30f, l_reg = 0;
  f32x16 o[4];
#pragma unroll
  for (int d = 0; d < 4; ++d)
#pragma unroll
    for (int r = 0; r < 16; ++r) o[d][r] = 0.f;
  constexpr int NQR = TWO ? 4 : DQK / 16;
  bf16x8 qr[NQR];
  const bf16_t* Qw = Qb + (size_t)(wid * 32 + r32) * ldq + hi * 8;
  char* qlds = lds + 2 * SHM_V + 2 * KT + 2048 + wid * 8192 + lane * 16;
#pragma unroll
  for (int d0 = 0; d0 < NQR; ++d0) qr[d0] = *(const bf16x8*)(Qw + d0 * 16);
#pragma unroll
  for (int d0 = NQR; d0 < DQK / 16; ++d0) *(bf16x8*)(qlds + (d0 - NQR) * 1024) = *(const bf16x8*)(Qw + d0 * 16);
  const int sr = tid >> 4, sc = (tid & 15) * 8, vst0 = v_st(sr, sc), vst1 = v_st(32 + sr, sc);
  const int vb0 = (int)(uintptr_t)V_lds + v_rd_base(lane);
  const unsigned voff = (unsigned)(sr * ldv + sc) * 2u, vstep = (unsigned)ldv * 64u;
  unsigned koff[NKP]; int klds[NKP];
#pragma unroll
  for (int i = 0; i < NKP; ++i) { const int p = tid + i * NTHR; const int kr = p / PPR, kc = (p % PPR) * 8; koff[i] = (unsigned)(kr * ldk + kc) * 2u; klds[i] = kr * KROW + kc * 2; }
  const int qpos = q0 + wid * 32 + r32;
  bf16x8 svs0, svs1, sks[NKP];
#define SLOAD(k0) do { const char* Vt_ = (const char*)(Vh + (size_t)(k0) * ldv); const char* Kt_ = (const char*)(Kh + (size_t)(k0) * ldk); \
    svs0 = *(const bf16x8*)(Vt_ + voff); svs1 = *(const bf16x8*)(Vt_ + vstep + voff); \
    _Pragma("unroll") for (int i_ = 0; i_ < NKP; ++i_) sks[i_] = *(const bf16x8*)(Kt_ + koff[i_]); } while (0)
#define SWRITE(b) do { *(bf16x8*)(V_lds + (b) * SHM_V + vst0) = svs0; *(bf16x8*)(V_lds + (b) * SHM_V + vst1) = svs1; \
    _Pragma("unroll") for (int i_ = 0; i_ < NKP; ++i_) *(bf16x8*)(K_lds + (b) * KT + klds[i_]) = sks[i_]; } while (0)
#define SWAIT() asm volatile("s_waitcnt vmcnt(0)" ::: "memory")
#define RESC(a) do { if (__any((a) < 1.f)) { if (hi == 0) al_l[r32] = (a); asm volatile("s_waitcnt lgkmcnt(0)" ::: "memory"); \
    _Pragma("unroll") for (int d = 0; d < 4; ++d) _Pragma("unroll") for (int r = 0; r < 16; ++r) o[d][r] *= al_l[crow(r, hi)]; } } while (0)
#define KDIFF(t) (kbeg + (t) * 64 + 4 * hi - qpos)
  bf16x8 pa0, pa1, pa2, pa3;
  if constexpr (TWO) {
  f32x16 pA0, pA1, pB0, pB1; float mnA, mnB, alA, alB;
  SLOAD(kbeg); SWAIT(); SWRITE(0); SLOAD(kbeg + 64); __syncthreads();
  qkt<DQK, NQR>(pA0, pA1, K_lds, qr, qlds, r32, hi); partialSM<WIN>(pA0, pA1, m_reg, mnA, alA, C, thr_raw, KDIFF(0));
  SWAIT(); SWRITE(1); __syncthreads();
  for (int j = 1; j + 1 < NT; j += 2) {
    SBAR(); qkt<DQK, NQR>(pB0, pB1, K_lds + KT, qr, qlds, r32, hi);
    finishSM(pA0, pA1, alA, l_reg, pa0, pa1, pa2, pa3); SBAR();
    SLOAD(kbeg + (j + 1) * 64); SBAR();
    pv_d0(o, vb0, pa0, pa1, pa2, pa3); partialSM<WIN>(pB0, pB1, m_reg, mnB, alB, C, thr_raw, KDIFF(j));
    __syncthreads(); SWAIT(); SWRITE(0);
    RESC(alB); __syncthreads();
    SBAR(); qkt<DQK, NQR>(pA0, pA1, K_lds, qr, qlds, r32, hi);
    finishSM(pB0, pB1, alB, l_reg, pa0, pa1, pa2, pa3); SBAR();
    SLOAD(kbeg + (j + 2) * 64); SBAR();
    pv_d0(o, vb0 + SHM_V, pa0, pa1, pa2, pa3); partialSM<WIN>(pA0, pA1, m_reg, mnA, alA, C, thr_raw, KDIFF(j + 1));
    __syncthreads(); SWAIT(); SWRITE(1);
    RESC(alA); __syncthreads();
  }
  SBAR(); qkt<DQK, NQR>(pB0, pB1, K_lds + KT, qr, qlds, r32, hi);
  finishSM(pA0, pA1, alA, l_reg, pa0, pa1, pa2, pa3); SBAR();
  pv_d0(o, vb0, pa0, pa1, pa2, pa3); partialSM<WIN>(pB0, pB1, m_reg, mnB, alB, C, thr_raw, KDIFF(NT - 1));
  __syncthreads(); RESC(alB);
  finishSM(pB0, pB1, alB, l_reg, pa0, pa1, pa2, pa3); SBAR();
  pv_d0(o, vb0 + SHM_V, pa0, pa1, pa2, pa3);
  } else {
  f32x16 pA0, pA1; float mnA, alA;
  SLOAD(kbeg); SWAIT(); SWRITE(0); __syncthreads();
  for (int j = 0; j < NT; ++j) {
    const int bf = j & 1;
    if (j + 1 < NT) SLOAD(kbeg + (j + 1) * 64);
    SBAR(); qkt<DQK, NQR>(pA0, pA1, K_lds + bf * KT, qr, qlds, r32, hi);
    partialSM<WIN>(pA0, pA1, m_reg, mnA, alA, C, thr_raw, KDIFF(j));
    RESC(alA);
    finishSM(pA0, pA1, alA, l_reg, pa0, pa1, pa2, pa3); SBAR();
    if (j + 1 < NT) { SWAIT(); if (bf) SWRITE(0); else SWRITE(1); }
    SBAR();
    pv_d0<false>(o, vb0 + bf * SHM_V, pa0, pa1, pa2, pa3);
    __syncthreads();
  }
  }
  if (WIN) l_reg += __builtin_amdgcn_exp2f(sink * 1.4426950408889634f - m_reg * C);
  if (hi == 0) li_l[r32] = l_reg; asm volatile("s_waitcnt lgkmcnt(0)" ::: "memory");
  const unsigned obase = (unsigned)((wid * 32 + 4 * hi) * ldo + r32) * 2u;
#pragma unroll
  for (int r = 0; r < 16; ++r) {
    const int dr = (r & 3) + 8 * (r >> 2); const float rl = __builtin_amdgcn_rcpf(li_l[dr + 4 * hi]);
    char* op = (char*)Ob + (obase + (unsigned)(dr * ldo) * 2u);
#pragma unroll
    for (int d0 = 0; d0 < 4; ++d0) *(bf16_t*)(op + d0 * 64) = f2bf(o[d0][r] * rl);
  }
  __syncthreads();
#undef SLOAD
#undef SWRITE
#undef SWAIT
#undef RESC
#undef KDIFF
}

DEV void gmlp_unit(int chunk, bf16_t* PROJ, const bf16_t* WSs, const float* __restrict__ ln_g, const float* __restrict__ ln_b, const float* __restrict__ b_s, char* lds) {
  const int tid = ltid(), wid = tid >> 6, lane = tid & 63, r32 = lane & 31, hi = lane >> 5;
  float* stats = (float*)(lds + 65536);
  const size_t t0 = (size_t)chunk * 128;
  for (int rr = 0; rr < 16; ++rr) {
    const int row = wid * 16 + rr;
    const bf16_t* vp = PROJ + (t0 + row) * INP + C_V;
    const u32x4 x0 = *(const u32x4*)(vp + lane * 8), x1 = *(const u32x4*)(vp + 512 + lane * 8);
    float s = 0.f, q = 0.f;
#pragma unroll
    for (int i = 0; i < 4; ++i) { float a = bflo(x0[i]), b = bfhi(x0[i]), c = bflo(x1[i]), d = bfhi(x1[i]); s += (a + b) + (c + d); q += (a * a + b * b) + (c * c + d * d); }
#pragma unroll
    for (int off = 32; off > 0; off >>= 1) { s += __shfl_xor(s, off); q += __shfl_xor(q, off); }
    if (lane == 0) { const float mean = s * (1.f / 1024.f); const float var = fmaxf(q * (1.f / 1024.f) - mean * mean, 0.f); stats[row * 2] = mean; stats[row * 2 + 1] = rsqrtf(var + EPS); }
  }
  __syncthreads();
  const int mi = wid & 3, wc = wid >> 2;
  const int vb = (int)(uintptr_t)lds + v_rd_base(lane) + wc * 1024;
  u32x4 xs[4];
#define GM_LOAD(g_) do { _Pragma("unroll") for (int i = 0; i < 4; ++i) { const int p = tid + i * NTHR, k = p >> 4, c = (p & 15) * 8; \
      xs[i] = *(const u32x4*)(PROJ + (t0 + k) * INP + C_V + (g_) * 128 + c); } } while (0)
#define GM_STAGE(g_) do { char* tb_ = lds + ((g_) & 1) * 32768; _Pragma("unroll") for (int i = 0; i < 4; ++i) { const int p = tid + i * NTHR, k = p >> 4, c = (p & 15) * 8; \
      const u32x4 x = xs[i]; const float mean = stats[k * 2], rstd = stats[k * 2 + 1]; \
      const f32x4 g0 = *(const f32x4*)(ln_g + (g_) * 128 + c), g1 = *(const f32x4*)(ln_g + (g_) * 128 + c + 4); \
      const f32x4 b0 = *(const f32x4*)(ln_b + (g_) * 128 + c), b1 = *(const f32x4*)(ln_b + (g_) * 128 + c + 4); \
      u32x4 w; \
      w[0] = cvtpk((bflo(x[0]) - mean) * rstd * g0[0] + b0[0], (bfhi(x[0]) - mean) * rstd * g0[1] + b0[1]); \
      w[1] = cvtpk((bflo(x[1]) - mean) * rstd * g0[2] + b0[2], (bfhi(x[1]) - mean) * rstd * g0[3] + b0[3]); \
      w[2] = cvtpk((bflo(x[2]) - mean) * rstd * g1[0] + b1[0], (bfhi(x[2]) - mean) * rstd * g1[1] + b1[1]); \
      w[3] = cvtpk((bflo(x[3]) - mean) * rstd * g1[2] + b1[2], (bfhi(x[3]) - mean) * rstd * g1[3] + b1[3]); \
      *(u32x4*)(tb_ + (k >> 6) * 16384 + v_st(k & 63, c)) = w; } } while (0)
  GM_LOAD(0); GM_STAGE(0);
  __syncthreads();
  for (int g = 0; g < 8; ++g) {
    if (g + 1 < 8) GM_LOAD(g + 1);
    bf16x8 a[8];
#pragma unroll
    for (int ks = 0; ks < 8; ++ks) a[ks] = *(const bf16x8*)(WSs + (size_t)g * 16384 + (32 * mi + r32) * 128 + ks * 16 + hi * 8);
    const int vbg = vb + (g & 1) * 32768;
    bf16_t uv[16][2];
#pragma unroll
    for (int r = 0; r < 16; ++r)
#pragma unroll
      for (int d = 0; d < 2; ++d) uv[r][d] = PROJ[(t0 + 32 * mi + crow(r, hi)) * INP + C_U + g * 128 + wc * 64 + d * 32 + r32];
    f32x16 od[2];
#pragma unroll
    for (int r = 0; r < 16; ++r) { od[0][r] = 0.f; od[1][r] = 0.f; }
    pv_one<0>(od[0], vbg, a[0], a[1], a[2], a[3]); pv_one<0>(od[0], vbg + 16384, a[4], a[5], a[6], a[7]);
    pv_one<1>(od[1], vbg, a[0], a[1], a[2], a[3]); pv_one<1>(od[1], vbg + 16384, a[4], a[5], a[6], a[7]);
    if (g + 1 < 8) GM_STAGE(g + 1);
#pragma unroll
    for (int r = 0; r < 16; ++r) {
      const int row = 32 * mi + crow(r, hi); const float bs = b_s[g * 128 + row];
#pragma unroll
      for (int d = 0; d < 2; ++d) {
        bf16_t* up = PROJ + (t0 + row) * INP + C_U + g * 128 + wc * 64 + d * 32 + r32;
        *up = f2bf(bf2f(uv[r][d]) * (od[d][r] + bs));
      }
    }
    __syncthreads();
  }
#undef GM_LOAD
#undef GM_STAGE
}

DEV void phase_cvt(const float* __restrict__ x, bf16_t* __restrict__ h, float* __restrict__ rs, int T, int gwave, int nwaves, int lane) {
  for (int row = gwave; row < T; row += nwaves) {
    f32x4 v[4]; float ss = 0.f;
#pragma unroll
    for (int i = 0; i < 4; ++i) { v[i] = *(const f32x4*)(x + (size_t)row * 1024 + i * 256 + lane * 4); ss += (v[i][0] * v[i][0] + v[i][1] * v[i][1]) + (v[i][2] * v[i][2] + v[i][3] * v[i][3]); }
#pragma unroll
    for (int off = 32; off > 0; off >>= 1) ss += __shfl_xor(ss, off);
    if (lane == 0) rs[row] = rsqrtf(ss * (1.f / 1024.f) + EPS);
#pragma unroll
    for (int i = 0; i < 4; ++i) { u32x2 w = {cvtpk(v[i][0], v[i][1]), cvtpk(v[i][2], v[i][3])}; *(u32x2*)(h + (size_t)row * 1024 + i * 256 + lane * 4) = w; }
  }
}
DEV void phase_resnorm(const bf16_t* __restrict__ y, const float* xin, const float* __restrict__ gain, float* xout, bf16_t* __restrict__ h, float* __restrict__ rsout, int T, int gwave, int nwaves, int lane) {
  constexpr int NB = 4;
  f32x4 gg[4];
#pragma unroll
  for (int i = 0; i < 4; ++i) gg[i] = *(const f32x4*)(gain + i * 256 + lane * 4);
  for (int row0 = gwave; row0 < T; row0 += NB * nwaves) {
    u32x2 yw[NB][4]; f32x4 xi[NB][4]; float ss[NB], s2[NB];
#pragma unroll
    for (int j = 0; j < NB; ++j)
#pragma unroll
      for (int i = 0; i < 4; ++i) yw[j][i] = *(const u32x2*)(y + (size_t)(row0 + j * nwaves) * 1024 + i * 256 + lane * 4);
#pragma unroll
    for (int j = 0; j < NB; ++j)
#pragma unroll
      for (int i = 0; i < 4; ++i) xi[j][i] = *(const f32x4*)(xin + (size_t)(row0 + j * nwaves) * 1024 + i * 256 + lane * 4);
#pragma unroll
    for (int j = 0; j < NB; ++j) { ss[j] = 0.f;
#pragma unroll
      for (int i = 0; i < 4; ++i) { const float a = bflo(yw[j][i][0]), b2 = bfhi(yw[j][i][0]), c = bflo(yw[j][i][1]), d = bfhi(yw[j][i][1]); ss[j] += (a * a + b2 * b2) + (c * c + d * d); } }
#pragma unroll
    for (int off = 32; off > 0; off >>= 1)
#pragma unroll
      for (int j = 0; j < NB; ++j) ss[j] += __shfl_xor(ss[j], off);
#pragma unroll
    for (int j = 0; j < NB; ++j) {
      const float rstd = rsqrtf(ss[j] * (1.f / 1024.f) + EPS); const size_t ro = (size_t)(row0 + j * nwaves) * 1024; s2[j] = 0.f;
#pragma unroll
      for (int i = 0; i < 4; ++i) {
        const int c = i * 256 + lane * 4;
        f32x4 o; o[0] = xi[j][i][0] + bflo(yw[j][i][0]) * rstd * gg[i][0]; o[1] = xi[j][i][1] + bfhi(yw[j][i][0]) * rstd * gg[i][1];
        o[2] = xi[j][i][2] + bflo(yw[j][i][1]) * rstd * gg[i][2]; o[3] = xi[j][i][3] + bfhi(yw[j][i][1]) * rstd * gg[i][3];
        s2[j] += (o[0] * o[0] + o[1] * o[1]) + (o[2] * o[2] + o[3] * o[3]);
        *(f32x4*)(xout + ro + c) = o;
        if (h) { u32x2 w = {cvtpk(o[0], o[1]), cvtpk(o[2], o[3])}; *(u32x2*)(h + ro + c) = w; }
      }
    }
    if (rsout) {
#pragma unroll
      for (int off = 32; off > 0; off >>= 1)
#pragma unroll
        for (int j = 0; j < NB; ++j) s2[j] += __shfl_xor(s2[j], off);
      if (lane == 0) {
#pragma unroll
        for (int j = 0; j < NB; ++j) rsout[row0 + j * nwaves] = rsqrtf(s2[j] * (1.f / 1024.f) + EPS);
      }
    }
  }
}

enum { MAP_ID = 0, MAP_IN = 1, MAP_UQ = 2, MAP_GU = 3 };
template <int MAP>
DEV void prep_w(bf16_t* __restrict__ dst, int Nd, int K, const float* __restrict__ src, const float* __restrict__ src2, int Ns, const float* __restrict__ gain, int gtid, int gsz) {
  const int kbn = K >> 3; const long total = (long)Nd * kbn;
  for (long idx = gtid; idx < total; idx += gsz) {
    const int n = (int)(idx % Nd), kb = (int)(idx / Nd);
    const float* s = src; int sc = n; bool zero = false;
    if (MAP == MAP_IN) {
      if (n >= C_END) zero = true;
      else if (n >= C_Q && n < C_VV) { const int j = (n - C_Q) & 127; sc = n - j + (j >> 1) + 64 * (j & 1); }
      else if (n >= C_KR && n < C_Q) { const int j = n - C_KR; sc = C_KR + (j >> 1) + 32 * (j & 1); }
    } else if (MAP == MAP_UQ) {
      const int h = n / 192, j = n % 192;
      if (j >= 128) { const int jj = j - 128; sc = h * 192 + 128 + (jj >> 1) + 32 * (jj & 1); }
    } else if (MAP == MAP_GU) {
      const int b = n >> 8, j = n & 255;
      if (j < 128) sc = b * 128 + j; else { s = src2; sc = b * 128 + j - 128; }
    }
    float v[8];
#pragma unroll
    for (int i = 0; i < 8; ++i) { const int k = kb * 8 + i; v[i] = zero ? 0.f : s[(size_t)k * Ns + sc] * (gain ? gain[k] : 1.f); }
    u32x4 w = {cvtpk(v[0], v[1]), cvtpk(v[2], v[3]), cvtpk(v[4], v[5]), cvtpk(v[6], v[7])};
    *(u32x4*)(dst + (size_t)n * K + kb * 8) = w;
  }
}

template <int KIND>
DEV void p2_epi(const f32x16& a, const float* rs, bf16_t* PROJ, unsigned ob, bf16_t* KM, const float2* RT, int pos0, int col) {
#pragma unroll
  for (int r = 0; r < 16; ++r) {
    const int dr = (r & 3) + 8 * (r >> 2);
    float v = a[r] * rs[dr];
    if (KIND == 0) PROJ[ob + dr * INP] = f2bf(gelu_t(v));
    else if (KIND == 1) PROJ[ob + dr * INP] = f2bf(v);
    else if (KIND == 4) PROJ[ob + dr * INP] = f2bf(sigm(v));
    else if (KIND == 3) {
      const float pr = __shfl_xor(v, 1); const int j = (col - C_Q) & 127;
      const float2 cs = RT[(pos0 + dr) * 64 + (j >> 1)];
      PROJ[ob + dr * INP] = f2bf((j & 1) ? (v * cs.x + pr * cs.y) : (v * cs.x - pr * cs.y));
    } else {
      const float pr = __shfl_xor(v, 1); const int j = col - C_KR;
      const float2 cs = RT[(pos0 + dr) * 32 + (j >> 1)];
      const bf16_t o = f2bf((j & 1) ? (v * cs.x + pr * cs.y) : (v * cs.x - pr * cs.y));
#pragma unroll
      for (int h = 0; h < 8; ++h) KM[ob + dr * 1536 + h * 192 + 128 + j] = o;
    }
  }
}
namespace pg8 {
#define PG8_LAS __attribute__((address_space(3)))
typedef unsigned short bf16_t;
typedef short bf16x8 __attribute__((ext_vector_type(8)));
typedef float f32x4 __attribute__((ext_vector_type(4)));
typedef unsigned u32x4 __attribute__((ext_vector_type(4)));
constexpr int BM = 256, BK = 64, HALF = 128, HTB = HALF * BK * 2  , STAGE_BYTES = 8 * HTB, NXCD = 8, WGM = 8;

__host__ __device__ __forceinline__ int lds_byte(int r, int c) { const int st = (r >> 4) * 2 + (c >> 5), rr = r & 15, cc = c & 31, ob = rr * 64 + cc * 2; return st * 1024 + (ob ^ (((ob >> 9) & 1) << 5)); }
__host__ __device__ __forceinline__ void stage_rc(int b, int& R, int& C) { const int st = b / 1024, sb = b % 1024, swz = sb ^ (((sb >> 9) & 1) << 5); R = (st >> 1) * 16 + swz / 64; C = (st & 1) * 32 + (swz % 64) / 2; }
__host__ __device__ __forceinline__ int perm32(int rho) { const int n = rho >> 4, i = rho & 15; return 8 * (i >> 2) + 4 * n + (i & 3); }

struct Unit { int pm, pn; };
struct Gemm { const bf16_t* A; const bf16_t* Bt; int M, N, K; };

struct StaticOrder {
    int nM, nN, nwg, G, c;
    __host__ __device__ void init(int M, int N, int G_, int c_) { nM = M / BM; nN = N / BM; nwg = nM * nN; G = G_; c = c_; }
    __host__ __device__ bool next(int i, Unit& u) const {
        const long L = (long)i * G + c; if (L >= nwg) return false;
        int wgid = (int)L; { const int q = nwg / NXCD, r = nwg % NXCD, xcd = wgid % NXCD, off = wgid / NXCD; wgid = (xcd < r ? xcd * (q + 1) : r * (q + 1) + (xcd - r) * q) + off; }
        const int nig = WGM * nN, gid = wgid / nig, fm = gid * WGM, gsz = (nM - fm) < WGM ? (nM - fm) : WGM;
        u.pm = fm + ((wgid % nig) % gsz); u.pn = (wgid % nig) / gsz; return true;
    }
    __device__ __forceinline__ void a_ready(const Unit&) const {}
    __device__ __forceinline__ void done(const Unit&) const {}
};


template <class Epi, class Sched, bool ALIGN_EPI = false, bool SP2 = false>
__device__ __forceinline__ void gemm_phase(PG8_LAS unsigned char* lds, const Gemm g, const Sched& S, const Epi& E, const int lda_in = 0) {
    const int tid = ltid(), wid = __builtin_amdgcn_readfirstlane(tid >> 6), lane = tid & 63, wr = wid >> 2, wc = wid & 3, fr = lane & 15, fq = lane >> 4;
    const int K = g.K, nt = K / BK, lda = lda_in ? lda_in : K;
    unsigned voffA[2], voffB[2];
#pragma unroll
    for (int i = 0; i < 2; ++i) { int R, C; stage_rc(tid * 16 + i * 8192, R, C); const int Rb = Epi::PERM ? ((R & ~31) + perm32(R & 31)) : R;
        voffA[i] = (unsigned)(R * lda + C) * 2u; voffB[i] = (unsigned)(Rb * K + C) * 2u; }
    const size_t kstep = (size_t)(BK * 2);
    const size_t hstep = (size_t)HALF * K * 2;
    const size_t tstep = 2 * hstep;
    const size_t hstepA = (size_t)HALF * lda * 2, tstepA = 2 * hstepA;
    const unsigned ldsw = (unsigned)wid * 1024u;
    const int aoff = lds_byte(wr * 64 + fr, fq * 8), boff = lds_byte(wc * 32 + fr, fq * 8);
#define PG8_SA(b, h) (((b) * 2 + (h)) * HTB)
#define PG8_SB(b, h) ((4 + (b) * 2 + (h)) * HTB)
#define PG8_STAGE(bufoff, gbase, voff) do { _Pragma("unroll") for (int _i = 0; _i < 2; ++_i) \
        __builtin_amdgcn_global_load_lds((const unsigned*)((const char*)(gbase) + (voff)[_i]), (PG8_LAS unsigned*)(lds + (bufoff) + ldsw + _i * 8192), 16, 0, 0); } while (0)
#define PG8_LDA(dst, b, h) do { _Pragma("unroll") for (int m = 0; m < 4; ++m) _Pragma("unroll") for (int k = 0; k < 2; ++k) dst[m][k] = *(const PG8_LAS bf16x8*)(lds + PG8_SA(b, h) + aoff + m * 2048 + k * 1024); } while (0)
#define PG8_LDB(dst, b, h) do { _Pragma("unroll") for (int n = 0; n < 2; ++n) _Pragma("unroll") for (int k = 0; k < 2; ++k) dst[n][k] = *(const PG8_LAS bf16x8*)(lds + PG8_SB(b, h) + boff + n * 2048 + k * 1024); } while (0)
#define PG8_MMA(ai, bj, At, Bt) do { __builtin_amdgcn_s_setprio(1); _Pragma("unroll") for (int m = 0; m < 4; ++m) _Pragma("unroll") for (int n = 0; n < 2; ++n) _Pragma("unroll") for (int k = 0; k < 2; ++k) \
        acc[ai][bj][m][n] = __builtin_amdgcn_mfma_f32_16x16x32_bf16(Bt[n][k], At[m][k], acc[ai][bj][m][n], 0, 0, 0); __builtin_amdgcn_s_setprio(0); } while (0)
#define PG8_WAIT_V(n) asm volatile("s_waitcnt vmcnt(" #n ")" ::: "memory")
#define PG8_WAIT_L(n) asm volatile("s_waitcnt lgkmcnt(" #n ")" ::: "memory")
#define PG8_BAR __builtin_amdgcn_s_barrier()
#define PG8_SCHED __builtin_amdgcn_sched_barrier(0)
    Unit cur, nxt; int ui = 0;
    if (!S.next(0, cur)) return;
    f32x4 acc[2][2][4][2];
#pragma unroll
    for (int a = 0; a < 2; ++a)
#pragma unroll
        for (int b = 0; b < 2; ++b)
#pragma unroll
            for (int m = 0; m < 4; ++m)
#pragma unroll
                for (int n = 0; n < 2; ++n) acc[a][b][m][n] = (f32x4){0.f, 0.f, 0.f, 0.f};
    bf16x8 At[4][2], B0[2][2], B1[2][2];
    const char* cA = (const char*)g.A + (size_t)cur.pm * tstepA; const char* cB = (const char*)g.Bt + (size_t)cur.pn * tstep;
    S.a_ready(cur);
    if constexpr (SP2) {
        PG8_STAGE(PG8_SB(0, 0), cB, voffB); PG8_STAGE(PG8_SB(0, 1), cB + hstep, voffB); PG8_STAGE(PG8_SA(0, 0), cA, voffA); PG8_STAGE(PG8_SA(0, 1), cA + hstepA, voffA);
        if (wr == 1) PG8_BAR;
        PG8_WAIT_V(2); PG8_BAR;
        PG8_STAGE(PG8_SB(1, 0), cB + kstep, voffB); PG8_STAGE(PG8_SA(1, 0), cA + kstep, voffA); PG8_STAGE(PG8_SB(1, 1), cB + hstep + kstep, voffB);
        PG8_WAIT_V(6); PG8_BAR;
    } else {
        PG8_STAGE(PG8_SB(0, 0), cB, voffB); PG8_STAGE(PG8_SA(0, 0), cA, voffA); PG8_STAGE(PG8_SB(0, 1), cB + hstep, voffB); PG8_STAGE(PG8_SA(0, 1), cA + hstepA, voffA);
        if (wr == 1) PG8_BAR;
        PG8_WAIT_V(4); PG8_BAR;
        PG8_STAGE(PG8_SB(1, 0), cB + kstep, voffB); PG8_STAGE(PG8_SA(1, 0), cA + kstep, voffA); PG8_STAGE(PG8_SB(1, 1), cB + hstep + kstep, voffB);
        PG8_WAIT_V(6); PG8_BAR;
    }
    for (;;) {
        const bool has_next = S.next(ui + 1, nxt);
        const char* nA = has_next ? (const char*)g.A + (size_t)nxt.pm * tstepA : cA; const char* nB = has_next ? (const char*)g.Bt + (size_t)nxt.pn * tstep : cB;
        for (int t = 0; t < nt; t += 2) {
            const bool last = (t == nt - 2);
            const char* a1 = cA + (size_t)(t + 1) * kstep;
            const char* a2 = last ? nA : cA + (size_t)(t + 2) * kstep; const char* b2 = last ? nB : cB + (size_t)(t + 2) * kstep;
            const char* a3 = a2 + kstep; const char* b3 = b2 + kstep;
            if (last && has_next) S.a_ready(nxt);
            if constexpr (SP2) {
            PG8_LDB(B0, 0, 0); PG8_LDB(B1, 0, 1); PG8_SCHED; PG8_LDA(At, 0, 0); PG8_STAGE(PG8_SA(1, 1), a1 + hstepA, voffA);
            PG8_WAIT_V(8); PG8_WAIT_L(0); PG8_BAR; PG8_MMA(0, 0, At, B0); PG8_MMA(0, 1, At, B1); PG8_BAR; PG8_SCHED;
            PG8_LDA(At, 0, 1); PG8_STAGE(PG8_SB(0, 0), b2, voffB); PG8_STAGE(PG8_SB(0, 1), b2 + hstep, voffB); PG8_STAGE(PG8_SA(0, 0), a2, voffA);
            PG8_WAIT_V(8); PG8_WAIT_L(0); PG8_BAR; PG8_MMA(1, 0, At, B0); PG8_MMA(1, 1, At, B1); PG8_BAR; PG8_SCHED;
            PG8_LDB(B0, 1, 0); PG8_LDB(B1, 1, 1); PG8_SCHED; PG8_LDA(At, 1, 0); PG8_STAGE(PG8_SA(0, 1), a2 + hstepA, voffA);
            PG8_WAIT_V(8); PG8_WAIT_L(0); PG8_BAR; PG8_MMA(0, 0, At, B0); PG8_MMA(0, 1, At, B1); PG8_BAR; PG8_SCHED;
            PG8_LDA(At, 1, 1); PG8_STAGE(PG8_SB(1, 0), b3, voffB); PG8_STAGE(PG8_SB(1, 1), b3 + hstep, voffB); PG8_STAGE(PG8_SA(1, 0), a3, voffA);
            PG8_WAIT_V(8); PG8_WAIT_L(0); PG8_BAR; PG8_MMA(1, 0, At, B0); PG8_MMA(1, 1, At, B1); PG8_BAR; PG8_SCHED;
            } else {
            PG8_LDB(B0, 0, 0); PG8_SCHED; PG8_LDA(At, 0, 0); PG8_STAGE(PG8_SA(1, 1), a1 + hstepA, voffA);
            PG8_WAIT_L(8); PG8_BAR; PG8_WAIT_L(0); PG8_MMA(0, 0, At, B0); PG8_BAR; PG8_SCHED;
            PG8_LDB(B1, 0, 1); PG8_STAGE(PG8_SB(0, 0), b2, voffB);
            PG8_BAR; PG8_WAIT_L(0); PG8_MMA(0, 1, At, B1); PG8_BAR;
            PG8_LDA(At, 0, 1); PG8_STAGE(PG8_SA(0, 0), a2, voffA);
            PG8_BAR; PG8_WAIT_L(0); PG8_MMA(1, 0, At, B0); PG8_BAR; PG8_SCHED;
            PG8_STAGE(PG8_SB(0, 1), b2 + hstep, voffB);
            PG8_WAIT_V(6); PG8_BAR; PG8_MMA(1, 1, At, B1); PG8_BAR;
            PG8_LDB(B0, 1, 0); PG8_SCHED; PG8_LDA(At, 1, 0); PG8_STAGE(PG8_SA(0, 1), a2 + hstepA, voffA);
            PG8_WAIT_L(8); PG8_BAR; PG8_WAIT_L(0); PG8_MMA(0, 0, At, B0); PG8_BAR; PG8_SCHED;
            PG8_LDB(B1, 1, 1); PG8_STAGE(PG8_SB(1, 0), b3, voffB);
            PG8_BAR; PG8_WAIT_L(0); PG8_MMA(0, 1, At, B1); PG8_BAR;
            PG8_LDA(At, 1, 1); PG8_STAGE(PG8_SA(1, 0), a3, voffA);
            PG8_BAR; PG8_WAIT_L(0); PG8_MMA(1, 0, At, B0); PG8_BAR; PG8_SCHED;
            PG8_STAGE(PG8_SB(1, 1), b3 + hstep, voffB);
            PG8_WAIT_V(6); PG8_BAR; PG8_MMA(1, 1, At, B1); PG8_BAR;
            }
        }
        if constexpr (ALIGN_EPI) { if (wr == 0) PG8_BAR; }
        if constexpr (!Epi::AFTER_DRAIN) { E(acc, cur, wr, wc, fr, fq); S.done(cur); }
        if (!has_next) break;
#pragma unroll
        for (int a = 0; a < 2; ++a)
#pragma unroll
            for (int b = 0; b < 2; ++b)
#pragma unroll
                for (int m = 0; m < 4; ++m)
#pragma unroll
                    for (int n = 0; n < 2; ++n) acc[a][b][m][n] = (f32x4){0.f, 0.f, 0.f, 0.f};
        cur = nxt; cA = nA; cB = nB; ++ui;
        if constexpr (ALIGN_EPI) { if (wr == 1) PG8_BAR; }
    }
    PG8_WAIT_V(0);
    if constexpr (!ALIGN_EPI) { if (wr == 0) PG8_BAR; }
    PG8_BAR;
    if constexpr (Epi::AFTER_DRAIN) { E.fused(acc, cur, wr, wc, fr, fq, lds, wid, lane); S.done(cur); }
#undef PG8_SA
#undef PG8_SB
#undef PG8_STAGE
#undef PG8_LDA
#undef PG8_LDB
#undef PG8_MMA
#undef PG8_WAIT_V
#undef PG8_WAIT_L
#undef PG8_BAR
#undef PG8_SCHED
}
}


struct EpiF32 {
  static constexpr bool PERM = false, AFTER_DRAIN = false;
  bf16_t* OUT;
  __device__ __forceinline__ void operator()(const pg8::f32x4 (&acc)[2][2][4][2], const pg8::Unit& u, int wr, int wc, int fr, int fq) const {
#pragma unroll
    for (int ai = 0; ai < 2; ++ai)
#pragma unroll
      for (int m = 0; m < 4; ++m) {
        bf16_t* rp = OUT + (size_t)(u.pm * 256 + ai * 128 + wr * 64 + m * 16 + fr) * 1024 + u.pn * 256 + wc * 32 + 4 * fq;
#pragma unroll
        for (int bj = 0; bj < 2; ++bj)
#pragma unroll
          for (int n = 0; n < 2; ++n) { const pg8::f32x4 v = acc[ai][bj][m][n]; u32x2 w; w[0] = cvtpk(v[0], v[1]); w[1] = cvtpk(v[2], v[3]); *(u32x2*)(rp + bj * 128 + n * 16) = w; }
      }
  }
};
struct EpiSwiGLU {
  static constexpr bool PERM = false, AFTER_DRAIN = false;
  bf16_t* TT; const float* RS;
  __device__ __forceinline__ void operator()(const pg8::f32x4 (&acc)[2][2][4][2], const pg8::Unit& u, int wr, int wc, int fr, int fq) const {
#pragma unroll
    for (int ai = 0; ai < 2; ++ai)
#pragma unroll
      for (int m = 0; m < 4; ++m) {
        const int row = u.pm * 256 + ai * 128 + wr * 64 + m * 16 + fr; const float rs = RS[row];
        bf16_t* rp = TT + (size_t)row * DFF + u.pn * 128 + wc * 32 + 4 * fq;
#pragma unroll
        for (int n = 0; n < 2; ++n) {
          const pg8::f32x4 g = acc[ai][0][m][n] * rs, uu = acc[ai][1][m][n] * rs;
          u32x2 w; w[0] = cvtpk(g[0] * sigm(g[0]) * uu[0], g[1] * sigm(g[1]) * uu[1]); w[1] = cvtpk(g[2] * sigm(g[2]) * uu[2], g[3] * sigm(g[3]) * uu[3]);
          *(u32x2*)(rp + n * 16) = w;
        }
      }
  }
};
struct EpiIn {
  static constexpr bool PERM = true, AFTER_DRAIN = false;
  bf16_t* PROJ; bf16_t* KM; const float2* R64; const float2* R128; const float* RS; int seqmask;
  __device__ __forceinline__ void operator()(const pg8::f32x4 (&acc)[2][2][4][2], const pg8::Unit& u, int wr, int wc, int fr, int fq) const {
#pragma unroll
    for (int bj = 0; bj < 2; ++bj) {
      const int cb = u.pn * 256 + bj * 128 + wc * 32;
      if (cb >= C_END) continue;
      const int kind = cb < C_CQL ? 0 : ((cb < C_KR || (cb >= C_VV && cb < C_G)) ? 1 : (cb < C_Q ? 2 : (cb < C_VV ? 3 : 4)));
      const int c0 = cb + 8 * fq;
#pragma unroll
      for (int ai = 0; ai < 2; ++ai)
#pragma unroll
        for (int m = 0; m < 4; ++m) {
          const int row = u.pm * 256 + ai * 128 + wr * 64 + m * 16 + fr; const float rs = RS[row]; const int pos = row & seqmask;
          u32x4 w;
#pragma unroll
          for (int n = 0; n < 2; ++n) {
            pg8::f32x4 v = acc[ai][bj][m][n] * rs;
            if (kind == 0) { v[0] = gelu_t(v[0]); v[1] = gelu_t(v[1]); v[2] = gelu_t(v[2]); v[3] = gelu_t(v[3]); }
            else if (kind == 4) { v[0] = sigm(v[0]); v[1] = sigm(v[1]); v[2] = sigm(v[2]); v[3] = sigm(v[3]); }
            else if (kind == 3 || kind == 2) {
              const pg8::f32x4 cs = kind == 3 ? *(const pg8::f32x4*)(R128 + pos * 64 + ((((c0 + 4 * n) - C_Q) & 127) >> 1))
                                              : *(const pg8::f32x4*)(R64 + pos * 32 + (((c0 + 4 * n) - C_KR) >> 1));
              const float a0 = v[0] * cs[0] - v[1] * cs[1], a1 = v[1] * cs[0] + v[0] * cs[1], a2 = v[2] * cs[2] - v[3] * cs[3], a3 = v[3] * cs[2] + v[2] * cs[3];
              v[0] = a0; v[1] = a1; v[2] = a2; v[3] = a3;
            }
            w[2 * n] = cvtpk(v[0], v[1]); w[2 * n + 1] = cvtpk(v[2], v[3]);
          }
          if (kind == 2) {
#pragma unroll
            for (int h = 0; h < 8; ++h) *(u32x4*)(KM + (size_t)row * 1536 + h * 192 + 128 + (c0 - C_KR)) = w;
          } else *(u32x4*)(PROJ + (size_t)row * INP + c0) = w;
        }
    }
  }
};

template <int STEP> struct EpiGate {
  static constexpr bool PERM = false, AFTER_DRAIN = false;
  const bf16_t* G; float* MACC; bf16_t* OUT;
  __device__ __forceinline__ void operator()(const pg8::f32x4 (&acc)[2][2][4][2], const pg8::Unit& u, int wr, int wc, int fr, int fq) const {
#pragma unroll
    for (int ai = 0; ai < 2; ++ai)
#pragma unroll
      for (int m = 0; m < 4; ++m) {
        const int row = u.pm * 256 + ai * 128 + wr * 64 + m * 16 + fr; const int c0 = u.pn * 256 + wc * 32 + 4 * fq;
#pragma unroll
        for (int bj = 0; bj < 2; ++bj)
#pragma unroll
          for (int n = 0; n < 2; ++n) {
            const int c = c0 + bj * 128 + n * 16;
            const u32x2 gw = *(const u32x2*)(G + (size_t)row * INP + c);
            pg8::f32x4 v = acc[ai][bj][m][n];
            v[0] *= bflo(gw[0]); v[1] *= bfhi(gw[0]); v[2] *= bflo(gw[1]); v[3] *= bfhi(gw[1]);
            float* mp = MACC + (size_t)row * 1024 + c;
            if (STEP > 0) v += *(const pg8::f32x4*)mp;
            if (STEP < 2) *(pg8::f32x4*)mp = v;
            else { u32x2 w; w[0] = cvtpk(v[0], v[1]); w[1] = cvtpk(v[2], v[3]); *(u32x2*)(OUT + (size_t)row * 1024 + c) = w; }
          }
      }
  }
};

#define LAS __attribute__((address_space(3)))
#define XB_TMO      128
#define XB_XCNT(j)  (256  + 64 * (j))
#define XB_XSUB(j)  (1280 + 64 * (j))
#define XB_XGEN(j)  (2304 + 64 * (j))
#define XB_TOP      3328
#define XB_TOPGEN   3392
#define XCD_BAR_WORDS 3456
#define XB_SPIN_CAP (1u << 22)

__device__ __forceinline__ unsigned xb_ld(unsigned* p)              { return __hip_atomic_load(p, __ATOMIC_RELAXED, __HIP_MEMORY_SCOPE_AGENT); }
__device__ __forceinline__ unsigned xb_add(unsigned* p, unsigned v) { return __hip_atomic_fetch_add(p, v, __ATOMIC_RELAXED, __HIP_MEMORY_SCOPE_AGENT); }
__device__ __forceinline__ unsigned xb_xcc_id() { return (unsigned)__builtin_amdgcn_s_getreg((3 << 11) | 20) & 0xFu; }
#define XB_SPIN(cond, bar) do { unsigned _sp = 0; while (cond) { __builtin_amdgcn_s_sleep(1); \
    if ((++_sp & 255u) == 0u) { if (xb_ld(&(bar)[XB_TMO])) break; if (_sp > XB_SPIN_CAP) { atomicAdd(&(bar)[XB_TMO], 1u); break; } } } } while (0)

struct XcdBarrier {
    unsigned* bar; unsigned x;
    volatile LAS unsigned* st;
};

__device__ __forceinline__ XcdBarrier xcd_barrier_post(unsigned* bar, volatile LAS unsigned* st) {
    XcdBarrier b; b.bar = bar; b.x = xb_xcc_id(); b.st = st;
    if (threadIdx.x == 0) (void)xb_add(&bar[XB_XCNT(b.x)], 1u);
    return b;
}
__device__ __forceinline__ void xcd_barrier_complete(unsigned* bar, unsigned x, unsigned& nloc, unsigned& nx) {
    const unsigned G = gridDim.x * gridDim.y * gridDim.z;
    unsigned sum, cnt, mine, sp = 0u;
    for (;;) {
        sum = 0u; cnt = 0u; mine = 0u;
#pragma unroll
        for (unsigned j = 0; j < 16; ++j) { const unsigned c = xb_ld(&bar[XB_XCNT(j)]); sum += c; cnt += (c > 0u) ? 1u : 0u; mine = (j == x) ? c : mine; }
        if (sum == G) break;
        __builtin_amdgcn_s_sleep(1);
        if ((++sp & 255u) == 0u) { if (xb_ld(&bar[XB_TMO])) break; if (sp > XB_SPIN_CAP) { atomicAdd(&bar[XB_TMO], 1u); break; } }
    }
    nloc = mine > 0u ? mine : 1u; nx = cnt > 0u ? cnt : 1u;
}

__device__ __forceinline__ void xcd_barrier(const XcdBarrier& b) {
    asm volatile("s_waitcnt vmcnt(0)" ::: "memory");
    __syncthreads();
    if (threadIdx.x == 0) {
        unsigned* bar = b.bar;
        __builtin_amdgcn_s_waitcnt(0);
        unsigned nloc = b.st[0], nx = b.st[1];
        if (nloc == 0u) { xcd_barrier_complete(bar, b.x, nloc, nx); b.st[0] = nloc; b.st[1] = nx; }
        const unsigned old = xb_add(&bar[XB_XSUB(b.x)], 1u);
        const unsigned gen = old / nloc;
        if (old + 1u == (gen + 1u) * nloc) {
            __builtin_amdgcn_fence(__ATOMIC_RELEASE, "agent");
            asm volatile("s_waitcnt vmcnt(0)" ::: "memory");
            const unsigned og = xb_add(&bar[XB_TOP], 1u);
            const unsigned tg = og / nx;
            if (og + 1u == (tg + 1u) * nx) xb_add(&bar[XB_TOPGEN], 1u);
            else XB_SPIN(xb_ld(&bar[XB_TOPGEN]) == tg, bar);
            __builtin_amdgcn_fence(__ATOMIC_ACQUIRE, "agent");
            xb_add(&bar[XB_XGEN(b.x)], 1u);
            asm volatile("s_waitcnt vmcnt(0)" ::: "memory");
        } else {
            XB_SPIN(xb_ld(&bar[XB_XGEN(b.x)]) == gen, bar);
            __builtin_amdgcn_fence(__ATOMIC_ACQUIRE, "agent");
            asm volatile("s_waitcnt vmcnt(0)" ::: "memory");
        }
    }
    __syncthreads();
}


DEV void tile_map(int u, int nM, int nN, int& pm, int& pn) {
  const int x = u & 7, t = u >> 3, ML = nM >> 3, per = 4 * nN;
  const int band = t / per, idx = t - band * per;
  pm = x * ML + band * 4 + (idx & 3); pn = idx >> 2;
}

#define TIDX() const int tid = ltid(), lane = tid & 63, wid = tid >> 6, r32 = lane & 31, hi = lane >> 5, wm = wid & 3, wn = wid >> 2; (void)lane; (void)wid; (void)r32; (void)hi; (void)wm; (void)wn
#define GTID() const int gtid = bid * NTHR + ltid(), gsz = nblk * NTHR
DEV void run_phase(const Params& p, const int grp, const int l, const int ph, char* lds) {
  const int nblk = gridDim.x, bid = blockIdx.x;
  char* ws = p.ws;
  float2* R128 = (float2*)(ws + O_R128); float2* R64 = (float2*)(ws + O_R64); float* RS1 = (float*)(ws + O_RS1); float* RS2 = (float*)(ws + O_RS2);
  bf16_t* HN = (bf16_t*)(ws + O_HN); bf16_t* PROJ = (bf16_t*)(ws + O_PROJ); bf16_t* QM = (bf16_t*)(ws + O_QM); bf16_t* KM = (bf16_t*)(ws + O_KM);
  bf16_t* VM = (bf16_t*)(ws + O_VM); bf16_t* YB = (bf16_t*)(ws + O_YB);
  bf16_t* MERGED = (bf16_t*)(ws + O_MERGED); bf16_t* MIX = (bf16_t*)(ws + O_MIX); bf16_t* H2 = (bf16_t*)(ws + O_H2); bf16_t* TT = (bf16_t*)(ws + O_TT); bf16_t* FF = (bf16_t*)(ws + O_FF);

  const int T = grp < 2 ? 32768 : 16384, seqlen = grp < 2 ? 8192 : 4096, nseq = 4;
  const float* xin0 = grp < 2 ? p.in[0] + (size_t)grp * 32768 * 1024 : p.in[1];
  float* xout = p.out + (size_t)(grp < 2 ? grp * 32768 : 65536) * 1024;
  const char* wl = ws + (size_t)l * WL;
  const float* xres = l == 0 ? xin0 : xout;
  if (ph == 0) {
  { GTID();
  for (int l = 0; l < 2; ++l) {
    char* wl = ws + (size_t)l * WL;
    prep_w<MAP_IN>((bf16_t*)(wl + O_WIN), INP, 1024, p.in[3] + (size_t)l * 1024 * 7360, nullptr, 7360, p.in[2] + l * 1024, gtid, gsz);
    prep_w<MAP_UQ>((bf16_t*)(wl + O_WUQ), 1536, 384, p.in[9] + (size_t)l * 384 * 1536, nullptr, 1536, p.in[8] + l * 384, gtid, gsz);
    prep_w<MAP_ID>((bf16_t*)(wl + O_WUKV), 2048, 256, p.in[11] + (size_t)l * 256 * 2048, nullptr, 2048, p.in[10] + l * 256, gtid, gsz);
    prep_w<MAP_ID>((bf16_t*)(wl + O_WPA), 1024, 1024, p.in[13] + (size_t)l * 1024 * 1024, nullptr, 1024, nullptr, gtid, gsz);
    prep_w<MAP_ID>((bf16_t*)(wl + O_WPB), 1024, 1024, p.in[14] + (size_t)l * 1024 * 1024, nullptr, 1024, nullptr, gtid, gsz);
    prep_w<MAP_ID>((bf16_t*)(wl + O_WPC), 1024, 1024, p.in[15] + (size_t)l * 1024 * 1024, nullptr, 1024, nullptr, gtid, gsz);
    prep_w<MAP_ID>((bf16_t*)(wl + O_WO), 1024, 1024, p.in[16] + (size_t)l * 1024 * 1024, nullptr, 1024, nullptr, gtid, gsz);
    prep_w<MAP_GU>((bf16_t*)(wl + O_WGU), 5632, 1024, p.in[19] + (size_t)l * 1024 * DFF, p.in[20] + (size_t)l * 1024 * DFF, DFF, p.in[18] + l * 1024, gtid, gsz);
    prep_w<MAP_ID>((bf16_t*)(wl + O_WD), 1024, DFF, p.in[21] + (size_t)l * DFF * 1024, nullptr, 1024, nullptr, gtid, gsz);
    { bf16_t* d = (bf16_t*)(wl + O_WS); const float* s = p.in[6] + (size_t)l * 8 * 128 * 128; for (int i = gtid; i < 8 * 128 * 128; i += gsz) d[i] = f2bf(s[i]); }
  }
  for (int i = gtid; i < 8192 * 64; i += gsz) { const int pos = i >> 6, f = i & 63; double rev = (double)pos * RPP128[f]; rev -= floor(rev); const float fr = (float)rev;
    R128[i] = make_float2(__builtin_amdgcn_cosf(fr), __builtin_amdgcn_sinf(fr)); }
  for (int i = gtid; i < 8192 * 32; i += gsz) { const int pos = i >> 5, f = i & 31; double rev = (double)pos * RPP64[f]; rev -= floor(rev); const float fr = (float)rev;
    R64[i] = make_float2(__builtin_amdgcn_cosf(fr), __builtin_amdgcn_sinf(fr)); }
  }
  }
  if (ph == 0) { TIDX(); phase_cvt(p.in[0], HN, RS1, 32768, bid * 8 + wid, nblk * 8, lane); }
      if (ph == 2) {
        pg8::Gemm g{HN, (const bf16_t*)(wl + O_WIN), T, INP, 1024};
        pg8::StaticOrder so; so.init(T, INP, nblk, bid);
        EpiIn e{PROJ, KM, R64, R128, RS1, seqlen - 1};
        pg8::gemm_phase<EpiIn, pg8::StaticOrder, true, true>((PG8_LAS unsigned char*)lds, g, so, e);
      }
      if (ph == 3) {
        const int nG = T / 128, nQ = (T / 256) * 6, nKV = (T / 256) * 8, nU = nG + nQ + nKV;
        for (int u = bid; u < nU; u += nblk) {
          if (u < nG) {
#ifndef NO_GMLP
            gmlp_unit(u, PROJ, (const bf16_t*)(wl + O_WS), p.in[4] + l * 1024, p.in[5] + l * 1024, p.in[7] + l * 1024, lds);
#endif
          } else if (u < nG + nQ) {
            const int v_ = u - nG, nM = T / 256; const int m0 = (v_ % nM) * 256, n0 = (v_ / nM) * 256;
            f32x16 acc[2][4]; float ss[2];
            gemm_mainloop<2, true>(acc, ss, PROJ + (size_t)m0 * INP + C_CQL, INP, (const bf16_t*)(wl + O_WUQ) + (size_t)n0 * 384, 384, 384, lds);
            rowss_finish<2>(ss, 384, lds);
            TIDX();
            const float* rs_l = (const float*)(lds + GemmCfg<2>::RS_OFF);
#pragma unroll
            for (int mi = 0; mi < 2; ++mi) {
              const int rbl = wm * 64 + mi * 32;
#pragma unroll
              for (int nf = 0; nf < 4; ++nf) {
                const int cb = n0 + wn * 128 + nf * 32, col = cb + r32; const int jb = cb % 192;
#pragma unroll
                for (int r = 0; r < 16; ++r) {
                  const int rl = rbl + crow(r, hi); const unsigned row = (unsigned)(m0 + rl);
                  float v = acc[mi][nf][r] * rs_l[rl];
                  if (jb >= 128) {
                    const float pr = __shfl_xor(v, 1); const int j = (jb - 128) + r32; const int pos = (int)row & (seqlen - 1);
                    const float2 cs = R64[pos * 32 + (j >> 1)];
                    v = (j & 1) ? (v * cs.x + pr * cs.y) : (v * cs.x - pr * cs.y);
                  }
                  QM[row * 1536 + col] = f2bf(v);
                }
              }
            }
          } else {
            const int v_ = u - nG - nQ, nM = T / 256; const int m0 = (v_ % nM) * 256, n0 = (v_ / nM) * 256;
            f32x16 acc[2][4]; float ss[2];
            gemm_mainloop<2, true>(acc, ss, PROJ + (size_t)m0 * INP + C_CKV, INP, (const bf16_t*)(wl + O_WUKV) + (size_t)n0 * 256, 256, 256, lds);
            rowss_finish<2>(ss, 256, lds);
            TIDX();
            const float* rs_l = (const float*)(lds + GemmCfg<2>::RS_OFF);
            const int h = n0 >> 8;
#pragma unroll
            for (int mi = 0; mi < 2; ++mi) {
              const int rbl = wm * 64 + mi * 32;
#pragma unroll
              for (int nf = 0; nf < 4; ++nf) {
                const int j = nf * 32 + r32;
#pragma unroll
                for (int r = 0; r < 16; ++r) {
                  const int rl = rbl + crow(r, hi); const unsigned row = (unsigned)(m0 + rl);
                  const bf16_t ob = f2bf(acc[mi][nf][r] * rs_l[rl]);
                  if (wn == 0) KM[row * 1536 + h * 192 + j] = ob; else VM[row * 1024 + h * 128 + j] = ob;
                }
              }
            }
          }
        }
      }
      if (ph == 4) {
        const int nqb = seqlen / 256, nU = nseq * 8 * nqb;
        for (int u = bid; u < nU; u += nblk) {
          const int b = u & 255, i = u >> 8; const int y = b >> 3; const int qb = y % nqb, sub = y / nqb;
          const int sh = (b & 7) + 8 * (i * (32 / nqb) + sub); const int s = sh >> 3, h = sh & 7;
          const size_t tq = (size_t)s * seqlen + (size_t)qb * 256, tk = (size_t)s * seqlen;
#ifndef NO_MLA
          attn_unit<192, false, false>(QM + tq * 1536 + h * 192, 1536, KM + tk * 1536 + h * 192, 1536, VM + tk * 1024 + h * 128, 1024,
                                YB + tq * 1024 + h * 128, 1024, 0, seqlen / 64, qb * 256, 0.f, 0.07216878364870322f, lds);
#else
          { const int t_ = ltid(); for (int e = t_; e < 256 * 128; e += NTHR) YB[(tq + (e >> 7)) * 1024 + h * 128 + (e & 127)] = 0; (void)tk; }
#endif
        }
        const float* sinkp = p.in[12] + l * 8;
        for (int u = bid; u < nU; u += nblk) {
          const int b = u & 255, i = u >> 8; const int y = b >> 3; const int qb = y % nqb, sub = y / nqb;
          const int sh = (b & 7) + 8 * (i * (32 / nqb) + sub); const int s = sh >> 3, h = sh & 7, kvh = h >> 2;
          const size_t tq = (size_t)s * seqlen + (size_t)qb * 256, tk = (size_t)s * seqlen;
          const int q0 = qb * 256; const int kb0 = q0 - 128 < 0 ? 0 : q0 - 128; const int ke = q0 + 384 > seqlen ? seqlen : q0 + 384;
#ifndef NO_GQA
          attn_unit<128, true, true>(PROJ + tq * INP + C_Q + h * 128, INP, PROJ + tk * INP + C_K + kvh * 128, INP, PROJ + tk * INP + C_VV + kvh * 128, INP,
                               PROJ + tq * INP + C_Q + h * 128, INP, kb0, (ke - kb0) / 64, q0, sinkp[h], 0.08838834764831845f, lds);
#else
          { const int t_ = ltid(); for (int e = t_; e < 256 * 128; e += NTHR) PROJ[(tq + (e >> 7)) * INP + C_Q + h * 128 + (e & 127)] = 0; (void)tk; (void)kvh; (void)kb0; (void)ke; (void)sinkp; }
#endif
        }
      }
      if (ph == 5) {
        float* MACC = (float*)(ws + O_QM);
        pg8::StaticOrder so; so.init(T, 1024, nblk, bid);
        { pg8::Gemm g{PROJ + C_U, (const bf16_t*)(wl + O_WPA), T, 1024, 1024}; EpiGate<0> e{PROJ + C_G, MACC, MERGED};
          pg8::gemm_phase<EpiGate<0>, pg8::StaticOrder, true, true>((PG8_LAS unsigned char*)lds, g, so, e, INP); }
        { pg8::Gemm g{YB, (const bf16_t*)(wl + O_WPB), T, 1024, 1024}; EpiGate<1> e{PROJ + C_G + 1024, MACC, MERGED};
          pg8::gemm_phase<EpiGate<1>, pg8::StaticOrder, true, true>((PG8_LAS unsigned char*)lds, g, so, e, 1024); }
        { pg8::Gemm g{PROJ + C_Q, (const bf16_t*)(wl + O_WPC), T, 1024, 1024}; EpiGate<2> e{PROJ + C_G + 2048, MACC, MERGED};
          pg8::gemm_phase<EpiGate<2>, pg8::StaticOrder, true, true>((PG8_LAS unsigned char*)lds, g, so, e, INP); }
      }
      if (ph == 6) {
        pg8::Gemm g{MERGED, (const bf16_t*)(wl + O_WO), T, 1024, 1024};
        pg8::StaticOrder so; so.init(T, 1024, nblk, bid);
        EpiF32 e{MIX};
        pg8::gemm_phase<EpiF32, pg8::StaticOrder, true, true>((PG8_LAS unsigned char*)lds, g, so, e);
      }
      if (ph == 7) { TIDX(); phase_resnorm(MIX, xres, p.in[17] + l * 1024, xout, H2, RS2, T, bid * 8 + wid, nblk * 8, lane); }
      if (ph == 8) {
        pg8::Gemm g{H2, (const bf16_t*)(wl + O_WGU), T, 5632, 1024};
        pg8::StaticOrder so; so.init(T, 5632, nblk, bid);
        EpiSwiGLU e{TT, RS2};
        pg8::gemm_phase<EpiSwiGLU, pg8::StaticOrder, true, true>((PG8_LAS unsigned char*)lds, g, so, e);
      }
      if (ph == 9) {
        pg8::Gemm g{TT, (const bf16_t*)(wl + O_WD), T, 1024, DFF};
        pg8::StaticOrder so; so.init(T, 1024, nblk, bid);
        EpiF32 e{FF};
        pg8::gemm_phase<EpiF32, pg8::StaticOrder, true, true>((PG8_LAS unsigned char*)lds, g, so, e);
      }
      if (ph == 10) { TIDX(); phase_resnorm(FF, xout, p.in[22] + l * 1024, xout, l == 0 ? HN : nullptr, l == 0 ? RS1 : nullptr, T, bid * 8 + wid, nblk * 8, lane);
        if (l == 1 && grp < 2) phase_cvt(grp == 0 ? p.in[0] + (size_t)32768 * 1024 : p.in[1], HN, RS1, grp == 0 ? 32768 : 16384, bid * 8 + wid, nblk * 8, lane); }
}

#define GSYNC() xcd_barrier(xb)
__global__ void __launch_bounds__(NTHR) mega(Params p) {
  extern __shared__ __attribute__((aligned(16))) char lds[];
  cg::grid_group grid = cg::this_grid();
  volatile LAS unsigned* bst = (volatile LAS unsigned*)(lds + 151552);
  if (threadIdx.x == 0) { bst[0] = 0u; bst[1] = 0u; }
  __syncthreads();
  const XcdBarrier xb = xcd_barrier_post((unsigned*)(p.ws + O_BAR), bst);
  grid.sync();
  run_phase(p, 0, 0, 0, lds);
  GSYNC();
  for (int grp = 0; grp < 3; ++grp) {
    for (int l = 0; l < 2; ++l)
      for (int ph = 2; ph <= 10; ++ph) { run_phase(p, grp, l, ph, lds); GSYNC(); }
  }
}
__global__ void __launch_bounds__(NTHR) phase_k(Params p, int grp, int l, int ph) {
  extern __shared__ __attribute__((aligned(16))) char lds[];
  run_phase(p, grp, l, ph, lds);
}

extern "C" void kernel_launch(void* const* d_in, const int* in_sizes, int n_in, void* d_out, int out_size, void* d_ws, size_t ws_size, hipStream_t stream) {
  static int grid_blocks = 0;
  if (!grid_blocks) {
    if (ws_size < WS_END) { fprintf(stderr, "kernel_launch: ws too small %zu < %zu\n", ws_size, (size_t)WS_END); return; }
    (void)hipFuncSetAttribute((const void*)mega, hipFuncAttributeMaxDynamicSharedMemorySize, LDS_BYTES);
    (void)hipFuncSetAttribute((const void*)phase_k, hipFuncAttributeMaxDynamicSharedMemorySize, LDS_BYTES);
    int dev = 0, cus = 0, per_cu = 0;
    hipGetDevice(&dev);
    hipDeviceGetAttribute(&cus, hipDeviceAttributeMultiprocessorCount, dev);
    hipOccupancyMaxActiveBlocksPerMultiprocessor(&per_cu, mega, NTHR, LDS_BYTES);
    if (per_cu < 1) per_cu = 1;
    grid_blocks = cus;
    if (grid_blocks > 256) grid_blocks = 256;
  }
  Params p;
  memset(&p, 0, sizeof(p));
  for (int i = 0; i < 23; ++i) p.in[i] = (const float*)d_in[i];
  p.out = (float*)d_out; p.ws = (char*)d_ws;
  (void)hipMemsetAsync((char*)d_ws + O_BAR, 0, 16384, stream);
#ifdef MULTI_LAUNCH
  auto launch = [&](int grp, int l, int ph) { hipLaunchKernelGGL(phase_k, dim3(grid_blocks), dim3(NTHR), LDS_BYTES, stream, p, grp, l, ph); };
  launch(0, 0, 0);
  for (int grp = 0; grp < 3; ++grp) { for (int l = 0; l < 2; ++l) for (int ph = 2; ph <= 10; ++ph) launch(grp, l, ph); }
#else
  void* args[] = {&p};
  hipError_t e = hipLaunchCooperativeKernel((void*)mega, dim3(grid_blocks), dim3(NTHR), args, LDS_BYTES, stream);
  if (e != hipSuccess) fprintf(stderr, "cooperative launch failed: %s (grid %d)\n", hipGetErrorString(e), grid_blocks);
#endif
}
```

```cpp
#include <hip/hip_runtime.h>
#include <hip/hip_cooperative_groups.h>
#include <cstdio>
#include <cmath>
#include <cstdint>
#include <cstring>
namespace cg = cooperative_groups;

#define DEV __device__ __forceinline__
typedef unsigned short bf16_t;
typedef short bf16x8 __attribute__((ext_vector_type(8)));
typedef short s16x4 __attribute__((ext_vector_type(4)));
typedef float f32x16 __attribute__((ext_vector_type(16)));
typedef float f32x4 __attribute__((ext_vector_type(4)));
typedef unsigned u32x4 __attribute__((ext_vector_type(4)));
typedef unsigned u32x2 __attribute__((ext_vector_type(2)));

constexpr int DM = 1024, INP = 7424, DFF = 2816, TG = 32768, NTHR = 512;
constexpr int C_U = 0, C_V = 1024, C_CQL = 2048, C_CKV = 2432, C_KR = 2688, C_Q = 2752, C_K = 3776, C_VV = 4032, C_G = 4288, C_END = 7360;
constexpr float EPS = 1e-6f;
constexpr size_t SZ_WIN = (size_t)INP * 1024 * 2, SZ_WUQ = (size_t)1536 * 384 * 2, SZ_WUKV = (size_t)2048 * 256 * 2, SZ_SQ = (size_t)1024 * 1024 * 2,
                 SZ_WGU = (size_t)5632 * 1024 * 2, SZ_WD = (size_t)1024 * DFF * 2, SZ_WS = (size_t)8 * 128 * 128 * 2;
constexpr size_t O_WIN = 0, O_WUQ = O_WIN + SZ_WIN, O_WUKV = O_WUQ + SZ_WUQ, O_WPA = O_WUKV + SZ_WUKV, O_WPB = O_WPA + SZ_SQ, O_WPC = O_WPB + SZ_SQ,
                 O_WO = O_WPC + SZ_SQ, O_WGU = O_WO + SZ_SQ, O_WD = O_WGU + SZ_WGU, O_WS = O_WD + SZ_WD, WL = O_WS + SZ_WS;
constexpr size_t O_R128 = 2 * WL, O_R64 = O_R128 + (size_t)8192 * 64 * 8, O_BAR = O_R64 + (size_t)8192 * 32 * 8, O_RS1 = O_BAR + 16384,
                  O_RS2 = O_RS1 + (size_t)TG * 4, O_ACT = O_RS2 + (size_t)TG * 4;
constexpr size_t O_HN = O_ACT, O_PROJ = O_HN + (size_t)TG * 1024 * 2, O_QM = O_PROJ + (size_t)TG * INP * 2, O_KM = O_QM + (size_t)TG * 1536 * 2,
                 O_VM = O_KM + (size_t)TG * 1536 * 2, O_YB = O_VM + (size_t)TG * 1024 * 2, WS_END = O_YB + (size_t)TG * 1024 * 2;
constexpr size_t O_MERGED = O_HN, O_MIX = O_QM, O_H2 = O_VM, O_TT = O_PROJ, O_FF = O_QM;
constexpr int LDS_BYTES = 151552 + 64;
#ifndef PH_MASK
#define PH_MASK 0xFFFF
#endif
#define PH(k) constexpr ((PH_MASK >> (k)) & 1)

struct Params {
  const float* in[23];
  float* out;
  char* ws;
};
__constant__ double RPP128[64] = {0.15915494309189535, 0.13782250260398285, 0.11934937021124886, 0.10335229661843406, 0.08949940160889101, 0.07750328875537404, 0.06711508300522726, 0.05811926744187624, 0.050329212104487035, 0.04358330210530733, 0.03774158471741978, 0.032682865872357, 0.028302195830623395, 0.024508691862069852, 0.02122365276477766, 0.018378926105679667, 0.015915494309189534, 0.013782250260398287, 0.011934937021124886, 0.010335229661843406, 0.0089499401608891, 0.0077503288755374055, 0.006711508300522725, 0.005811926744187624, 0.005032921210448704, 0.004358330210530732, 0.0037741584717419768, 0.0032682865872357, 0.00283021958306234, 0.002450869186206985, 0.0021223652764777662, 0.0018378926105679669, 0.0015915494309189536, 0.0013782250260398283, 0.0011934937021124887, 0.0010335229661843407, 0.0008949940160889102, 0.0007750328875537407, 0.0006711508300522726, 0.0005811926744187624, 0.0005032921210448703, 0.0004358330210530733, 0.0003774158471741977, 0.0003268286587235699, 0.000283021958306234, 0.0002450869186206985, 0.0002122365276477766, 0.00018378926105679666, 0.00015915494309189535, 0.00013782250260398286, 0.00011934937021124885, 0.00010335229661843405, 8.949940160889102e-05, 7.750328875537406e-05, 6.711508300522727e-05, 5.811926744187624e-05, 5.0329212104487035e-05, 4.358330210530733e-05, 3.774158471741978e-05, 3.2682865872357e-05, 2.8302195830623396e-05, 2.4508691862069852e-05, 2.122365276477766e-05, 1.8378926105679668e-05};
__constant__ double RPP64[32] = {0.15915494309189535, 0.11934937021124886, 0.08949940160889101, 0.06711508300522726, 0.050329212104487035, 0.03774158471741978, 0.028302195830623395, 0.02122365276477766, 0.015915494309189534, 0.011934937021124886, 0.0089499401608891, 0.006711508300522725, 0.005032921210448704, 0.0037741584717419768, 0.00283021958306234, 0.0021223652764777662, 0.0015915494309189536, 0.0011934937021124887, 0.0008949940160889102, 0.0006711508300522726, 0.0005032921210448703, 0.0003774158471741977, 0.000283021958306234, 0.0002122365276477766, 0.00015915494309189535, 0.00011934937021124885, 8.949940160889102e-05, 6.711508300522727e-05, 5.0329212104487035e-05, 3.774158471741978e-05, 2.8302195830623396e-05, 2.122365276477766e-05};
DEV int ltid() { int t = threadIdx.x; asm volatile("" : "+v"(t)); return t; }

typedef __bf16 bf16x2_t __attribute__((ext_vector_type(2)));
typedef float f32x2 __attribute__((ext_vector_type(2)));
DEV unsigned cvtpk(float lo, float hi) { f32x2 v = {lo, hi}; bf16x2_t b = __builtin_convertvector(v, bf16x2_t); return __builtin_bit_cast(unsigned, b); }
DEV bf16_t f2bf(float x) { return (bf16_t)(cvtpk(x, 0.f) & 0xffffu); }
DEV float bf2f(bf16_t u) { return __uint_as_float(((unsigned)u) << 16); }
DEV float bflo(unsigned w) { return __uint_as_float(w << 16); }
DEV float bfhi(unsigned w) { return __uint_as_float(w & 0xffff0000u); }
DEV int crow(int r, int hi) { return (r & 3) + 8 * (r >> 2) + 4 * hi; }
DEV float gelu_t(float x) { float z = 0.7978845608f * (x + 0.044715f * x * x * x); return x * __builtin_amdgcn_rcpf(1.f + __expf(-2.f * z)); }
DEV float sigm(float x) { return __builtin_amdgcn_rcpf(1.f + __expf(-x)); }
#define SBAR() __builtin_amdgcn_sched_barrier(0)

constexpr int G_ROWB = 144;
template <int MI> struct GemmCfg { static constexpr int TM = 128 * MI, AB = TM * G_ROWB, BB = 256 * G_ROWB, STAGE = AB + BB, RS_OFF = 2 * STAGE; };

template <int MI, bool ROWSS>
DEV void gemm_mainloop(f32x16 (&acc)[MI][4], float (&ss)[MI], const bf16_t* __restrict__ A, int lda, const bf16_t* __restrict__ Bt, int ldb, int K, char* lds) {
  using C = GemmCfg<MI>;
  const int tid = ltid(), lane = tid & 63, wid = tid >> 6, r32 = lane & 31, hi = lane >> 5, wm = wid & 3, wn = wid >> 2;
  u32x4 ra[2 * MI], rb[4];
  const int prow = tid >> 3, pkc = (tid & 7) * 8;
  const bf16_t* ga = A + (size_t)prow * lda + pkc;
  const bf16_t* gb = Bt + (size_t)prow * ldb + pkc;
  const int lw = prow * G_ROWB + pkc * 2;
  const int aoff = (wm * 32 * MI + r32) * G_ROWB + hi * 16;
  const int boff = C::AB + (wn * 128 + r32) * G_ROWB + hi * 16;
#pragma unroll
  for (int mi = 0; mi < MI; ++mi) {
    ss[mi] = 0.f;
#pragma unroll
    for (int nf = 0; nf < 4; ++nf)
#pragma unroll
      for (int r = 0; r < 16; ++r) acc[mi][nf][r] = 0.f;
  }
  const int nk = K >> 6;
#define G_LOAD(kt_) do { const int k0_ = (kt_) << 6; \
    _Pragma("unroll") for (int i = 0; i < 2 * MI; ++i) ra[i] = *(const u32x4*)(ga + (size_t)i * 64 * lda + k0_); \
    _Pragma("unroll") for (int i = 0; i < 4; ++i) rb[i] = *(const u32x4*)(gb + (size_t)i * 64 * ldb + k0_); } while (0)
#define G_WRITE(s_) do { char* wb_ = lds + (s_) * C::STAGE; \
    _Pragma("unroll") for (int i = 0; i < 2 * MI; ++i) *(u32x4*)(wb_ + lw + i * 64 * G_ROWB) = ra[i]; \
    _Pragma("unroll") for (int i = 0; i < 4; ++i) *(u32x4*)(wb_ + C::AB + lw + i * 64 * G_ROWB) = rb[i]; } while (0)
  G_LOAD(0); G_WRITE(0); G_LOAD(1);
  __syncthreads();
  for (int kt = 0; kt < nk; ++kt) {
    const char* base = lds + (kt & 1) * C::STAGE;
    SBAR();
#pragma unroll
    for (int ks = 0; ks < 4; ++ks) {
      bf16x8 a[MI], b[4];
#pragma unroll
      for (int mi = 0; mi < MI; ++mi) a[mi] = *(const bf16x8*)(base + aoff + mi * 32 * G_ROWB + ks * 32);
#pragma unroll
      for (int nf = 0; nf < 4; ++nf) b[nf] = *(const bf16x8*)(base + boff + nf * 32 * G_ROWB + ks * 32);
      if (ROWSS) {
#pragma unroll
        for (int mi = 0; mi < MI; ++mi)
#pragma unroll
          for (int j = 0; j < 8; ++j) { float f = bf2f((bf16_t)a[mi][j]); ss[mi] += f * f; }
      }
      __builtin_amdgcn_s_setprio(1);
#pragma unroll
      for (int mi = 0; mi < MI; ++mi)
#pragma unroll
        for (int nf = 0; nf < 4; ++nf) acc[mi][nf] = __builtin_amdgcn_mfma_f32_32x32x16_bf16(a[mi], b[nf], acc[mi][nf], 0, 0, 0);
      __builtin_amdgcn_s_setprio(0);
    }
    SBAR();
    if (kt + 1 < nk) { G_WRITE((kt + 1) & 1); if (kt + 2 < nk) G_LOAD(kt + 2); }
    __syncthreads();
  }
#undef G_LOAD
#undef G_WRITE
}

template <int MI>
DEV void rowss_finish(float (&ss)[MI], int K, char* lds) {
  using C = GemmCfg<MI>;
  const int tid = ltid(), lane = tid & 63, wid = tid >> 6, r32 = lane & 31, hi = lane >> 5, wm = wid & 3, wn = wid >> 2;
  float* rs_l = (float*)(lds + C::RS_OFF);
#pragma unroll
  for (int mi = 0; mi < MI; ++mi) {
    float t = ss[mi] + __shfl_xor(ss[mi], 32);
    if (wn == 0 && hi == 0) rs_l[wm * 32 * MI + mi * 32 + r32] = rsqrtf(t / (float)K + EPS);
  }
  __syncthreads();
}

DEV int v_st(int k, int c) { const int kk = (k & ~0xC) | ((k & 4) << 1) | ((k & 8) >> 1); return ((kk >> 3) * 4 + (c >> 5)) * 512 + ((kk & 7) * 32 + (c & 31)) * 2; }
DEV int v_rd_base(int lane) { return ((lane & 3) << 3) | (((lane >> 2) & 3) << 6) | (((lane >> 4) & 1) << 5) | (((lane >> 5) & 1) << 8); }
constexpr int v_rd_off(int d0, int ks, int half) { return d0 * 512 + ks * 4096 + half * 2048; }
template <int OFF> DEV s16x4 tr_read(int vb) { s16x4 r; asm volatile("ds_read_b64_tr_b16 %0, %1 offset:%2" : "=&v"(r) : "v"(vb), "i"(OFF) : "memory"); return r; }
template <int D0, bool SPLIT = true> DEV void pv_one(f32x16& od, int vb, bf16x8 pa0, bf16x8 pa1, bf16x8 pa2, bf16x8 pa3) {
#define PK(L, H) (bf16x8){L[0], L[1], L[2], L[3], H[0], H[1], H[2], H[3]}
  if constexpr (SPLIT) {
  {
    const s16x4 l0 = tr_read<v_rd_off(D0, 0, 0)>(vb), h0 = tr_read<v_rd_off(D0, 0, 1)>(vb), l1 = tr_read<v_rd_off(D0, 1, 0)>(vb), h1 = tr_read<v_rd_off(D0, 1, 1)>(vb);
    asm volatile("s_waitcnt lgkmcnt(0)" ::: "memory"); SBAR();
    od = __builtin_amdgcn_mfma_f32_32x32x16_bf16(pa0, PK(l0, h0), od, 0, 0, 0);
    od = __builtin_amdgcn_mfma_f32_32x32x16_bf16(pa1, PK(l1, h1), od, 0, 0, 0);
  }
  {
    const s16x4 l2 = tr_read<v_rd_off(D0, 2, 0)>(vb), h2 = tr_read<v_rd_off(D0, 2, 1)>(vb), l3 = tr_read<v_rd_off(D0, 3, 0)>(vb), h3 = tr_read<v_rd_off(D0, 3, 1)>(vb);
    asm volatile("s_waitcnt lgkmcnt(0)" ::: "memory"); SBAR();
    od = __builtin_amdgcn_mfma_f32_32x32x16_bf16(pa2, PK(l2, h2), od, 0, 0, 0);
    od = __builtin_amdgcn_mfma_f32_32x32x16_bf16(pa3, PK(l3, h3), od, 0, 0, 0);
  }
  } else {
    const s16x4 l0 = tr_read<v_rd_off(D0, 0, 0)>(vb), h0 = tr_read<v_rd_off(D0, 0, 1)>(vb), l1 = tr_read<v_rd_off(D0, 1, 0)>(vb), h1 = tr_read<v_rd_off(D0, 1, 1)>(vb);
    const s16x4 l2 = tr_read<v_rd_off(D0, 2, 0)>(vb), h2 = tr_read<v_rd_off(D0, 2, 1)>(vb), l3 = tr_read<v_rd_off(D0, 3, 0)>(vb), h3 = tr_read<v_rd_off(D0, 3, 1)>(vb);
    asm volatile("s_waitcnt lgkmcnt(0)" ::: "memory"); SBAR();
    od = __builtin_amdgcn_mfma_f32_32x32x16_bf16(pa0, PK(l0, h0), od, 0, 0, 0);
    od = __builtin_amdgcn_mfma_f32_32x32x16_bf16(pa1, PK(l1, h1), od, 0, 0, 0);
    od = __builtin_amdgcn_mfma_f32_32x32x16_bf16(pa2, PK(l2, h2), od, 0, 0, 0);
    od = __builtin_amdgcn_mfma_f32_32x32x16_bf16(pa3, PK(l3, h3), od, 0, 0, 0);
  }
#undef PK
}
template <bool SPLIT = true> DEV void pv_d0(f32x16* o, int vb, bf16x8 pa0, bf16x8 pa1, bf16x8 pa2, bf16x8 pa3) {
  pv_one<0, SPLIT>(o[0], vb, pa0, pa1, pa2, pa3); pv_one<1, SPLIT>(o[1], vb, pa0, pa1, pa2, pa3); pv_one<2, SPLIT>(o[2], vb, pa0, pa1, pa2, pa3); pv_one<3, SPLIT>(o[3], vb, pa0, pa1, pa2, pa3);
}

template <bool WIN>
DEV void partialSM(f32x16& p0, f32x16& p1, float& m_reg, float& mn, float& alpha, const float C, const float thr_raw, int kdiff) {
  if (WIN) {
#pragma unroll
    for (int r = 0; r < 16; ++r) {
      const int d = kdiff + (r & 3) + 8 * (r >> 2);
      if (d > 128 || d < -128) p0[r] = -INFINITY;
      if (d + 32 > 128 || d + 32 < -128) p1[r] = -INFINITY;
    }
  }
  float pmax = p0[0];
#pragma unroll
  for (int r = 1; r < 16; ++r) pmax = fmaxf(pmax, p0[r]);
#pragma unroll
  for (int r = 0; r < 16; ++r) pmax = fmaxf(pmax, p1[r]);
  { auto rr = __builtin_amdgcn_permlane32_swap(__float_as_uint(pmax), __float_as_uint(pmax), false, false);
    pmax = fmaxf(__uint_as_float(rr[0]), __uint_as_float(rr[1])); }
  if (__builtin_expect(__all(pmax - m_reg <= thr_raw), 1)) { mn = m_reg; alpha = 1.f; }
  else { mn = fmaxf(m_reg, pmax); alpha = __builtin_amdgcn_exp2f((m_reg - mn) * C); m_reg = mn; }
  const float mnC = -mn * C;
#pragma unroll
  for (int r = 0; r < 16; ++r) p0[r] = fmaf(p0[r], C, mnC);
#pragma unroll
  for (int r = 0; r < 16; ++r) p1[r] = fmaf(p1[r], C, mnC);
#pragma unroll
  for (int r = 0; r < 16; ++r) p0[r] = __builtin_amdgcn_exp2f(p0[r]);
}
DEV void finishSM(f32x16& p0, f32x16& p1, float alpha, float& l_reg, bf16x8& pa0, bf16x8& pa1, bf16x8& pa2, bf16x8& pa3) {
#pragma unroll
  for (int r = 0; r < 16; ++r) p1[r] = __builtin_amdgcn_exp2f(p1[r]);
  float ps = 0;
#pragma unroll
  for (int r = 0; r < 16; ++r) ps += p0[r];
#pragma unroll
  for (int r = 0; r < 16; ++r) ps += p1[r];
  { auto rr = __builtin_amdgcn_permlane32_swap(__float_as_uint(ps), __float_as_uint(ps), false, false);
    ps = __uint_as_float(rr[0]) + __uint_as_float(rr[1]); }
  l_reg = l_reg * alpha + ps;
#define PK4(P, BASE, OUT) do { unsigned a0 = cvtpk(P[BASE + 0], P[BASE + 1]), a1 = cvtpk(P[BASE + 2], P[BASE + 3]);   \
    unsigned b0 = cvtpk(P[BASE + 4], P[BASE + 5]), b1 = cvtpk(P[BASE + 6], P[BASE + 7]);                              \
    auto r0 = __builtin_amdgcn_permlane32_swap(a0, b0, false, false); auto r1 = __builtin_amdgcn_permlane32_swap(a1, b1, false, false); \
    u32x4 w = {r0[0], r1[0], r0[1], r1[1]}; OUT = *reinterpret_cast<bf16x8*>(&w); } while (0)
  PK4(p0, 0, pa0); PK4(p0, 8, pa1); PK4(p1, 0, pa2); PK4(p1, 8, pa3);
#undef PK4
}

template <int DQK> struct ACfg { static constexpr int KROW = DQK * 2 + 16, KT = 64 * KROW, NKP = (64 * (DQK / 8)) / NTHR, PPR = DQK / 8; };

template <int DQK, int NQR>
DEV void qkt(f32x16& p0, f32x16& p1, const char* Ks, const bf16x8* qr, const char* qlds_, int r32, int hi) {
  constexpr int KROW = ACfg<DQK>::KROW;
  unsigned qa = (unsigned)(uintptr_t)qlds_; asm volatile("" : "+v"(qa));
  const __attribute__((address_space(3))) char* qlds = (const __attribute__((address_space(3))) char*)qa;
#pragma unroll
  for (int r = 0; r < 16; ++r) { p0[r] = 0.f; p1[r] = 0.f; }
#pragma unroll
  for (int d0 = 0; d0 < DQK / 16; ++d0) {
    const int cb = (d0 * 16 + hi * 8) * 2;
    bf16x8 b0 = *reinterpret_cast<const bf16x8*>(Ks + r32 * KROW + cb);
    bf16x8 b1 = *reinterpret_cast<const bf16x8*>(Ks + (32 + r32) * KROW + cb);
    bf16x8 q;
    if (d0 < NQR) q = qr[d0 < NQR ? d0 : 0]; else q = *reinterpret_cast<const __attribute__((address_space(3))) bf16x8*>(qlds + (d0 - NQR) * 1024);
    p0 = __builtin_amdgcn_mfma_f32_32x32x16_bf16(b0, q, p0, 0, 0, 0);
    p1 = __builtin_amdgcn_mfma_f32_32x32x16_bf16(b1, q, p1, 0, 0, 0);
    if (NQR < DQK / 16 && (d0 & 3) == 3) SBAR();
  }
}

template <int DQK, bool WIN, bool TWO>
DEV void attn_unit(const bf16_t* Qb, int ldq, const bf16_t* __restrict__ Kh, int ldk, const bf16_t* __restrict__ Vh, int ldv,
                   bf16_t* Ob, int ldo, int kbeg, int NT, int q0, float sink, const float SCALE, char* lds) {
  using CF = ACfg<DQK>;
  constexpr int KROW = CF::KROW, KT = CF::KT, NKP = CF::NKP, PPR = CF::PPR, SHM_V = 16384;
  const float C = SCALE * 1.4426950408889634f, thr_raw = 8.f / SCALE;
  const int tid = ltid(), wid = tid >> 6, lane = tid & 63, r32 = lane & 31, hi = lane >> 5;
  char* V_lds = lds; char* K_lds = lds + 2 * SHM_V;
  float* wsf = (float*)(lds + 2 * SHM_V + 2 * KT) + wid * 64; float* li_l = wsf; float* al_l = wsf + 32;
  float m_reg = -1e30f, l_reg = 0;
  f32x16 o[4];
#pragma unroll
  for (int d = 0; d < 4; ++d)
#pragma unroll
    for (int r = 0; r < 16; ++r) o[d][r] = 0.f;
  constexpr int NQR = TWO ? 4 : DQK / 16;
  bf16x8 qr[NQR];
  const bf16_t* Qw = Qb + (size_t)(wid * 32 + r32) * ldq + hi * 8;
  char* qlds = lds + 2 * SHM_V + 2 * KT + 2048 + wid * 8192 + lane * 16;
#pragma unroll
  for (int d0 = 0; d0 < NQR; ++d0) qr[d0] = *(const bf16x8*)(Qw + d0 * 16);
#pragma unroll
  for (int d0 = NQR; d0 < DQK / 16; ++d0) *(bf16x8*)(qlds + (d0 - NQR) * 1024) = *(const bf16x8*)(Qw + d0 * 16);
  const int sr = tid >> 4, sc = (tid & 15) * 8, vst0 = v_st(sr, sc), vst1 = v_st(32 + sr, sc);
  const int vb0 = (int)(uintptr_t)V_lds + v_rd_base(lane);
  const unsigned voff = (unsigned)(sr * ldv + sc) * 2u, vstep = (unsigned)ldv * 64u;
  unsigned koff[NKP]; int klds[NKP];
#pragma unroll
  for (int i = 0; i < NKP; ++i) { const int p = tid + i * NTHR; const int kr = p / PPR, kc = (p % PPR) * 8; koff[i] = (unsigned)(kr * ldk + kc) * 2u; klds[i] = kr * KROW + kc * 2; }
  const int qpos = q0 + wid * 32 + r32;
  bf16x8 svs0, svs1, sks[NKP];
#define SLOAD(k0) do { const char* Vt_ = (const char*)(Vh + (size_t)(k0) * ldv); const char* Kt_ = (const char*)(Kh + (size_t)(k0) * ldk); \
    svs0 = *(const bf16x8*)(Vt_ + voff); svs1 = *(const bf16x8*)(Vt_ + vstep + voff); \
    _Pragma("unroll") for (int i_ = 0; i_ < NKP; ++i_) sks[i_] = *(const bf16x8*)(Kt_ + koff[i_]); } while (0)
#define SWRITE(b) do { *(bf16x8*)(V_lds + (b) * SHM_V + vst0) = svs0; *(bf16x8*)(V_lds + (b) * SHM_V + vst1) = svs1; \
    _Pragma("unroll") for (int i_ = 0; i_ < NKP; ++i_) *(bf16x8*)(K_lds + (b) * KT + klds[i_]) = sks[i_]; } while (0)
#define SWAIT() asm volatile("s_waitcnt vmcnt(0)" ::: "memory")
#define RESC(a) do { if (__any((a) < 1.f)) { if (hi == 0) al_l[r32] = (a); asm volatile("s_waitcnt lgkmcnt(0)" ::: "memory"); \
    _Pragma("unroll") for (int d = 0; d < 4; ++d) _Pragma("unroll") for (int r = 0; r < 16; ++r) o[d][r] *= al_l[crow(r, hi)]; } } while (0)
#define KDIFF(t) (kbeg + (t) * 64 + 4 * hi - qpos)
  bf16x8 pa0, pa1, pa2, pa3;
  if constexpr (TWO) {
  f32x16 pA0, pA1, pB0, pB1; float mnA, mnB, alA, alB;
  SLOAD(kbeg); SWAIT(); SWRITE(0); SLOAD(kbeg + 64); __syncthreads();
  qkt<DQK, NQR>(pA0, pA1, K_lds, qr, qlds, r32, hi); partialSM<WIN>(pA0, pA1, m_reg, mnA, alA, C, thr_raw, KDIFF(0));
  SWAIT(); SWRITE(1); __syncthreads();
  for (int j = 1; j + 1 < NT; j += 2) {
    SBAR(); qkt<DQK, NQR>(pB0, pB1, K_lds + KT, qr, qlds, r32, hi);
    finishSM(pA0, pA1, alA, l_reg, pa0, pa1, pa2, pa3); SBAR();
    SLOAD(kbeg + (j + 1) * 64); SBAR();
    pv_d0(o, vb0, pa0, pa1, pa2, pa3); partialSM<WIN>(pB0, pB1, m_reg, mnB, alB, C, thr_raw, KDIFF(j));
    __syncthreads(); SWAIT(); SWRITE(0);
    RESC(alB); __syncthreads();
    SBAR(); qkt<DQK, NQR>(pA0, pA1, K_lds, qr, qlds, r32, hi);
    finishSM(pB0, pB1, alB, l_reg, pa0, pa1, pa2, pa3); SBAR();
    SLOAD(kbeg + (j + 2) * 64); SBAR();
    pv_d0(o, vb0 + SHM_V, pa0, pa1, pa2, pa3); partialSM<WIN>(pA0, pA1, m_reg, mnA, alA, C, thr_raw, KDIFF(j + 1));
    __syncthreads(); SWAIT(); SWRITE(1);
    RESC(alA); __syncthreads();
  }
  SBAR(); qkt<DQK, NQR>(pB0, pB1, K_lds + KT, qr, qlds, r32, hi);
  finishSM(pA0, pA1, alA, l_reg, pa0, pa1, pa2, pa3); SBAR();
  pv_d0(o, vb0, pa0, pa1, pa2, pa3); partialSM<WIN>(pB0, pB1, m_reg, mnB, alB, C, thr_raw, KDIFF(NT - 1));
  __syncthreads(); RESC(alB);
  finishSM(pB0, pB1, alB, l_reg, pa0, pa1, pa2, pa3); SBAR();
  pv_d0(o, vb0 + SHM_V, pa0, pa1, pa2, pa3);
  } else {
  f32x16 pA0, pA1; float mnA, alA;
  SLOAD(kbeg); SWAIT(); SWRITE(0); __syncthreads();
  for (int j = 0; j < NT; ++j) {
    const int bf = j & 1;
    if (j + 1 < NT) SLOAD(kbeg + (j + 1) * 64);
    SBAR(); qkt<DQK, NQR>(pA0, pA1, K_lds + bf * KT, qr, qlds, r32, hi);
    partialSM<WIN>(pA0, pA1, m_reg, mnA, alA, C, thr_raw, KDIFF(j));
    RESC(alA);
    finishSM(pA0, pA1, alA, l_reg, pa0, pa1, pa2, pa3); SBAR();
    if (j + 1 < NT) { SWAIT(); if (bf) SWRITE(0); else SWRITE(1); }
    SBAR();
    pv_d0<false>(o, vb0 + bf * SHM_V, pa0, pa1, pa2, pa3);
    __syncthreads();
  }
  }
  if (WIN) l_reg += __builtin_amdgcn_exp2f(sink * 1.4426950408889634f - m_reg * C);
  if (hi == 0) li_l[r32] = l_reg; asm volatile("s_waitcnt lgkmcnt(0)" ::: "memory");
  const unsigned obase = (unsigned)((wid * 32 + 4 * hi) * ldo + r32) * 2u;
#pragma unroll
  for (int r = 0; r < 16; ++r) {
    const int dr = (r & 3) + 8 * (r >> 2); const float rl = __builtin_amdgcn_rcpf(li_l[dr + 4 * hi]);
    char* op = (char*)Ob + (obase + (unsigned)(dr * ldo) * 2u);
#pragma unroll
    for (int d0 = 0; d0 < 4; ++d0) *(bf16_t*)(op + d0 * 64) = f2bf(o[d0][r] * rl);
  }
  __syncthreads();
#undef SLOAD
#undef SWRITE
#undef SWAIT
#undef RESC
#undef KDIFF
}

DEV void gmlp_unit(int chunk, bf16_t* PROJ, const bf16_t* WSs, const float* __restrict__ ln_g, const float* __restrict__ ln_b, const float* __restrict__ b_s, char* lds) {
  const int tid = ltid(), wid = tid >> 6, lane = tid & 63, r32 = lane & 31, hi = lane >> 5;
  float* stats = (float*)(lds + 65536);
  const size_t t0 = (size_t)chunk * 128;
  for (int rr = 0; rr < 16; ++rr) {
    const int row = wid * 16 + rr;
    const bf16_t* vp = PROJ + (t0 + row) * INP + C_V;
    const u32x4 x0 = *(const u32x4*)(vp + lane * 8), x1 = *(const u32x4*)(vp + 512 + lane * 8);
    float s = 0.f, q = 0.f;
#pragma unroll
    for (int i = 0; i < 4; ++i) { float a = bflo(x0[i]), b = bfhi(x0[i]), c = bflo(x1[i]), d = bfhi(x1[i]); s += (a + b) + (c + d); q += (a * a + b * b) + (c * c + d * d); }
#pragma unroll
    for (int off = 32; off > 0; off >>= 1) { s += __shfl_xor(s, off); q += __shfl_xor(q, off); }
    if (lane == 0) { const float mean = s * (1.f / 1024.f); const float var = fmaxf(q * (1.f / 1024.f) - mean * mean, 0.f); stats[row * 2] = mean; stats[row * 2 + 1] = rsqrtf(var + EPS); }
  }
  __syncthreads();
  const int mi = wid & 3, wc = wid >> 2;
  const int vb = (int)(uintptr_t)lds + v_rd_base(lane) + wc * 1024;
  u32x4 xs[4];
#define GM_LOAD(g_) do { _Pragma("unroll") for (int i = 0; i < 4; ++i) { const int p = tid + i * NTHR, k = p >> 4, c = (p & 15) * 8; \
      xs[i] = *(const u32x4*)(PROJ + (t0 + k) * INP + C_V + (g_) * 128 + c); } } while (0)
#define GM_STAGE(g_) do { char* tb_ = lds + ((g_) & 1) * 32768; _Pragma("unroll") for (int i = 0; i < 4; ++i) { const int p = tid + i * NTHR, k = p >> 4, c = (p & 15) * 8; \
      const u32x4 x = xs[i]; const float mean = stats[k * 2], rstd = stats[k * 2 + 1]; \
      const f32x4 g0 = *(const f32x4*)(ln_g + (g_) * 128 + c), g1 = *(const f32x4*)(ln_g + (g_) * 128 + c + 4); \
      const f32x4 b0 = *(const f32x4*)(ln_b + (g_) * 128 + c), b1 = *(const f32x4*)(ln_b + (g_) * 128 + c + 4); \
      u32x4 w; \
      w[0] = cvtpk((bflo(x[0]) - mean) * rstd * g0[0] + b0[0], (bfhi(x[0]) - mean) * rstd * g0[1] + b0[1]); \
      w[1] = cvtpk((bflo(x[1]) - mean) * rstd * g0[2] + b0[2], (bfhi(x[1]) - mean) * rstd * g0[3] + b0[3]); \
      w[2] = cvtpk((bflo(x[2]) - mean) * rstd * g1[0] + b1[0], (bfhi(x[2]) - mean) * rstd * g1[1] + b1[1]); \
      w[3] = cvtpk((bflo(x[3]) - mean) * rstd * g1[2] + b1[2], (bfhi(x[3]) - mean) * rstd * g1[3] + b1[3]); \
      *(u32x4*)(tb_ + (k >> 6) * 16384 + v_st(k & 63, c)) = w; } } while (0)
  GM_LOAD(0); GM_STAGE(0);
  bf16x8 a[8];
#pragma unroll
  for (int ks = 0; ks < 8; ++ks) a[ks] = *(const bf16x8*)(WSs + (32 * mi + r32) * 128 + ks * 16 + hi * 8);
  __syncthreads();
  for (int g = 0; g < 8; ++g) {
    if (g + 1 < 8) GM_LOAD(g + 1);
    const int vbg = vb + (g & 1) * 32768;
    bf16_t uv[16][2];
#pragma unroll
    for (int r = 0; r < 16; ++r)
#pragma unroll
      for (int d = 0; d < 2; ++d) uv[r][d] = PROJ[(t0 + 32 * mi + crow(r, hi)) * INP + C_U + g * 128 + wc * 64 + d * 32 + r32];
    f32x16 od[2];
#pragma unroll
    for (int r = 0; r < 16; ++r) { od[0][r] = 0.f; od[1][r] = 0.f; }
    pv_one<0>(od[0], vbg, a[0], a[1], a[2], a[3]); pv_one<0>(od[0], vbg + 16384, a[4], a[5], a[6], a[7]);
    pv_one<1>(od[1], vbg, a[0], a[1], a[2], a[3]); pv_one<1>(od[1], vbg + 16384, a[4], a[5], a[6], a[7]);
    if (g + 1 < 8) {
#pragma unroll
      for (int ks = 0; ks < 8; ++ks) a[ks] = *(const bf16x8*)(WSs + (size_t)(g + 1) * 16384 + (32 * mi + r32) * 128 + ks * 16 + hi * 8);
      GM_STAGE(g + 1);
    }
#pragma unroll
    for (int r = 0; r < 16; ++r) {
      const int row = 32 * mi + crow(r, hi); const float bs = b_s[g * 128 + row];
#pragma unroll
      for (int d = 0; d < 2; ++d) {
        bf16_t* up = PROJ + (t0 + row) * INP + C_U + g * 128 + wc * 64 + d * 32 + r32;
        *up = f2bf(bf2f(uv[r][d]) * (od[d][r] + bs));
      }
    }
    __syncthreads();
  }
#undef GM_LOAD
#undef GM_STAGE
}

DEV void phase_cvt(const float* __restrict__ x, bf16_t* __restrict__ h, float* __restrict__ rs, int T, int gwave, int nwaves, int lane) {
  for (int row = gwave; row < T; row += nwaves) {
    f32x4 v[4]; float ss = 0.f;
#pragma unroll
    for (int i = 0; i < 4; ++i) { v[i] = *(const f32x4*)(x + (size_t)row * 1024 + i * 256 + lane * 4); ss += (v[i][0] * v[i][0] + v[i][1] * v[i][1]) + (v[i][2] * v[i][2] + v[i][3] * v[i][3]); }
#pragma unroll
    for (int off = 32; off > 0; off >>= 1) ss += __shfl_xor(ss, off);
    if (lane == 0) rs[row] = rsqrtf(ss * (1.f / 1024.f) + EPS);
#pragma unroll
    for (int i = 0; i < 4; ++i) { u32x2 w = {cvtpk(v[i][0], v[i][1]), cvtpk(v[i][2], v[i][3])}; *(u32x2*)(h + (size_t)row * 1024 + i * 256 + lane * 4) = w; }
  }
}
DEV void phase_resnorm(const bf16_t* __restrict__ y, const float* xin, const float* __restrict__ gain, float* xout, bf16_t* __restrict__ h, float* __restrict__ rsout, int T, int gwave, int nwaves, int lane) {
  constexpr int NB = 4;
  f32x4 gg[4];
#pragma unroll
  for (int i = 0; i < 4; ++i) gg[i] = *(const f32x4*)(gain + i * 256 + lane * 4);
  for (int row0 = gwave; row0 < T; row0 += NB * nwaves) {
    u32x2 yw[NB][4]; f32x4 xi[NB][4]; float ss[NB], s2[NB];
#pragma unroll
    for (int j = 0; j < NB; ++j)
#pragma unroll
      for (int i = 0; i < 4; ++i) yw[j][i] = *(const u32x2*)(y + (size_t)(row0 + j * nwaves) * 1024 + i * 256 + lane * 4);
#pragma unroll
    for (int j = 0; j < NB; ++j)
#pragma unroll
      for (int i = 0; i < 4; ++i) xi[j][i] = *(const f32x4*)(xin + (size_t)(row0 + j * nwaves) * 1024 + i * 256 + lane * 4);
#pragma unroll
    for (int j = 0; j < NB; ++j) { ss[j] = 0.f;
#pragma unroll
      for (int i = 0; i < 4; ++i) { const float a = bflo(yw[j][i][0]), b2 = bfhi(yw[j][i][0]), c = bflo(yw[j][i][1]), d = bfhi(yw[j][i][1]); ss[j] += (a * a + b2 * b2) + (c * c + d * d); } }
#pragma unroll
    for (int off = 32; off > 0; off >>= 1)
#pragma unroll
      for (int j = 0; j < NB; ++j) ss[j] += __shfl_xor(ss[j], off);
#pragma unroll
    for (int j = 0; j < NB; ++j) {
      const float rstd = rsqrtf(ss[j] * (1.f / 1024.f) + EPS); const size_t ro = (size_t)(row0 + j * nwaves) * 1024; s2[j] = 0.f;
#pragma unroll
      for (int i = 0; i < 4; ++i) {
        const int c = i * 256 + lane * 4;
        f32x4 o; o[0] = xi[j][i][0] + bflo(yw[j][i][0]) * rstd * gg[i][0]; o[1] = xi[j][i][1] + bfhi(yw[j][i][0]) * rstd * gg[i][1];
        o[2] = xi[j][i][2] + bflo(yw[j][i][1]) * rstd * gg[i][2]; o[3] = xi[j][i][3] + bfhi(yw[j][i][1]) * rstd * gg[i][3];
        s2[j] += (o[0] * o[0] + o[1] * o[1]) + (o[2] * o[2] + o[3] * o[3]);
        *(f32x4*)(xout + ro + c) = o;
        if (h) { u32x2 w = {cvtpk(o[0], o[1]), cvtpk(o[2], o[3])}; *(u32x2*)(h + ro + c) = w; }
      }
    }
    if (rsout) {
#pragma unroll
      for (int off = 32; off > 0; off >>= 1)
#pragma unroll
        for (int j = 0; j < NB; ++j) s2[j] += __shfl_xor(s2[j], off);
      if (lane == 0) {
#pragma unroll
        for (int j = 0; j < NB; ++j) rsout[row0 + j * nwaves] = rsqrtf(s2[j] * (1.f / 1024.f) + EPS);
      }
    }
  }
}

enum { MAP_ID = 0, MAP_IN = 1, MAP_UQ = 2, MAP_GU = 3 };
template <int MAP>
DEV void prep_w(bf16_t* __restrict__ dst, int Nd, int K, const float* __restrict__ src, const float* __restrict__ src2, int Ns, const float* __restrict__ gain, int gtid, int gsz) {
  const int kbn = K >> 3; const long total = (long)Nd * kbn;
  for (long idx = gtid; idx < total; idx += gsz) {
    const int n = (int)(idx % Nd), kb = (int)(idx / Nd);
    const float* s = src; int sc = n; bool zero = false;
    if (MAP == MAP_IN) {
      if (n >= C_END) zero = true;
      else if (n >= C_Q && n < C_VV) { const int j = (n - C_Q) & 127; sc = n - j + (j >> 1) + 64 * (j & 1); }
      else if (n >= C_KR && n < C_Q) { const int j = n - C_KR; sc = C_KR + (j >> 1) + 32 * (j & 1); }
    } else if (MAP == MAP_UQ) {
      const int h = n / 192, j = n % 192;
      if (j >= 128) { const int jj = j - 128; sc = h * 192 + 128 + (jj >> 1) + 32 * (jj & 1); }
    } else if (MAP == MAP_GU) {
      const int b = n >> 8, j = n & 255;
      if (j < 128) sc = b * 128 + j; else { s = src2; sc = b * 128 + j - 128; }
    }
    float v[8];
#pragma unroll
    for (int i = 0; i < 8; ++i) { const int k = kb * 8 + i; v[i] = zero ? 0.f : s[(size_t)k * Ns + sc] * (gain ? gain[k] : 1.f); }
    u32x4 w = {cvtpk(v[0], v[1]), cvtpk(v[2], v[3]), cvtpk(v[4], v[5]), cvtpk(v[6], v[7])};
    *(u32x4*)(dst + (size_t)n * K + kb * 8) = w;
  }
}

template <int KIND>
DEV void p2_epi(const f32x16& a, const float* rs, bf16_t* PROJ, unsigned ob, bf16_t* KM, const float2* RT, int pos0, int col) {
#pragma unroll
  for (int r = 0; r < 16; ++r) {
    const int dr = (r & 3) + 8 * (r >> 2);
    float v = a[r] * rs[dr];
    if (KIND == 0) PROJ[ob + dr * INP] = f2bf(gelu_t(v));
    else if (KIND == 1) PROJ[ob + dr * INP] = f2bf(v);
    else if (KIND == 4) PROJ[ob + dr * INP] = f2bf(sigm(v));
    else if (KIND == 3) {
      const float pr = __shfl_xor(v, 1); const int j = (col - C_Q) & 127;
      const float2 cs = RT[(pos0 + dr) * 64 + (j >> 1)];
      PROJ[ob + dr * INP] = f2bf((j & 1) ? (v * cs.x + pr * cs.y) : (v * cs.x - pr * cs.y));
    } else {
      const float pr = __shfl_xor(v, 1); const int j = col - C_KR;
      const float2 cs = RT[(pos0 + dr) * 32 + (j >> 1)];
      const bf16_t o = f2bf((j & 1) ? (v * cs.x + pr * cs.y) : (v * cs.x - pr * cs.y));
#pragma unroll
      for (int h = 0; h < 8; ++h) KM[ob + dr * 1536 + h * 192 + 128 + j] = o;
    }
  }
}
namespace pg8 {
#define PG8_LAS __attribute__((address_space(3)))
typedef unsigned short bf16_t;
typedef short bf16x8 __attribute__((ext_vector_type(8)));
typedef float f32x4 __attribute__((ext_vector_type(4)));
typedef unsigned u32x4 __attribute__((ext_vector_type(4)));
constexpr int BM = 256, BK = 64, HALF = 128, HTB = HALF * BK * 2  , STAGE_BYTES = 8 * HTB, NXCD = 8, WGM = 8;

__host__ __device__ __forceinline__ int lds_byte(int r, int c) { const int st = (r >> 4) * 2 + (c >> 5), rr = r & 15, cc = c & 31, ob = rr * 64 + cc * 2; return st * 1024 + (ob ^ (((ob >> 9) & 1) << 5)); }
__host__ __device__ __forceinline__ void stage_rc(int b, int& R, int& C) { const int st = b / 1024, sb = b % 1024, swz = sb ^ (((sb >> 9) & 1) << 5); R = (st >> 1) * 16 + swz / 64; C = (st & 1) * 32 + (swz % 64) / 2; }
__host__ __device__ __forceinline__ int perm32(int rho) { const int n = rho >> 4, i = rho & 15; return 8 * (i >> 2) + 4 * n + (i & 3); }

struct Unit { int pm, pn; };
struct Gemm { const bf16_t* A; const bf16_t* Bt; int M, N, K; };

struct StaticOrder {
    int nM, nN, nwg, G, c;
    __host__ __device__ void init(int M, int N, int G_, int c_) { nM = M / BM; nN = N / BM; nwg = nM * nN; G = G_; c = c_; }
    __host__ __device__ bool next(int i, Unit& u) const {
        const long L = (long)i * G + c; if (L >= nwg) return false;
        int wgid = (int)L; { const int q = nwg / NXCD, r = nwg % NXCD, xcd = wgid % NXCD, off = wgid / NXCD; wgid = (xcd < r ? xcd * (q + 1) : r * (q + 1) + (xcd - r) * q) + off; }
        const int nig = WGM * nN, gid = wgid / nig, fm = gid * WGM, gsz = (nM - fm) < WGM ? (nM - fm) : WGM;
        u.pm = fm + ((wgid % nig) % gsz); u.pn = (wgid % nig) / gsz; return true;
    }
    __device__ __forceinline__ void a_ready(const Unit&) const {}
    __device__ __forceinline__ void done(const Unit&) const {}
};


template <class Epi, class Sched, bool ALIGN_EPI = false, bool SP2 = false>
__device__ __forceinline__ void gemm_phase(PG8_LAS unsigned char* lds, const Gemm g, const Sched& S, const Epi& E, const int lda_in = 0) {
    const int tid = ltid(), wid = __builtin_amdgcn_readfirstlane(tid >> 6), lane = tid & 63, wr = wid >> 2, wc = wid & 3, fr = lane & 15, fq = lane >> 4;
    const int K = g.K, nt = K / BK, lda = lda_in ? lda_in : K;
    unsigned voffA[2], voffB[2];
#pragma unroll
    for (int i = 0; i < 2; ++i) { int R, C; stage_rc(tid * 16 + i * 8192, R, C); const int Rb = Epi::PERM ? ((R & ~31) + perm32(R & 31)) : R;
        voffA[i] = (unsigned)(R * lda + C) * 2u; voffB[i] = (unsigned)(Rb * K + C) * 2u; }
    const size_t kstep = (size_t)(BK * 2);
    const size_t hstep = (size_t)HALF * K * 2;
    const size_t tstep = 2 * hstep;
    const size_t hstepA = (size_t)HALF * lda * 2, tstepA = 2 * hstepA;
    const unsigned ldsw = (unsigned)wid * 1024u;
    const int aoff = lds_byte(wr * 64 + fr, fq * 8), boff = lds_byte(wc * 32 + fr, fq * 8);
#define PG8_SA(b, h) (((b) * 2 + (h)) * HTB)
#define PG8_SB(b, h) ((4 + (b) * 2 + (h)) * HTB)
#define PG8_STAGE(bufoff, gbase, voff) do { _Pragma("unroll") for (int _i = 0; _i < 2; ++_i) \
        __builtin_amdgcn_global_load_lds((const unsigned*)((const char*)(gbase) + (voff)[_i]), (PG8_LAS unsigned*)(lds + (bufoff) + ldsw + _i * 8192), 16, 0, 0); } while (0)
#define PG8_LDA(dst, b, h) do { _Pragma("unroll") for (int m = 0; m < 4; ++m) _Pragma("unroll") for (int k = 0; k < 2; ++k) dst[m][k] = *(const PG8_LAS bf16x8*)(lds + PG8_SA(b, h) + aoff + m * 2048 + k * 1024); } while (0)
#define PG8_LDB(dst, b, h) do { _Pragma("unroll") for (int n = 0; n < 2; ++n) _Pragma("unroll") for (int k = 0; k < 2; ++k) dst[n][k] = *(const PG8_LAS bf16x8*)(lds + PG8_SB(b, h) + boff + n * 2048 + k * 1024); } while (0)
#define PG8_MMA(ai, bj, At, Bt) do { __builtin_amdgcn_s_setprio(1); _Pragma("unroll") for (int m = 0; m < 4; ++m) _Pragma("unroll") for (int n = 0; n < 2; ++n) _Pragma("unroll") for (int k = 0; k < 2; ++k) \
        acc[ai][bj][m][n] = __builtin_amdgcn_mfma_f32_16x16x32_bf16(Bt[n][k], At[m][k], acc[ai][bj][m][n], 0, 0, 0); __builtin_amdgcn_s_setprio(0); } while (0)
#define PG8_WAIT_V(n) asm volatile("s_waitcnt vmcnt(" #n ")" ::: "memory")
#define PG8_WAIT_L(n) asm volatile("s_waitcnt lgkmcnt(" #n ")" ::: "memory")
#define PG8_BAR __builtin_amdgcn_s_barrier()
#define PG8_SCHED __builtin_amdgcn_sched_barrier(0)
    Unit cur, nxt; int ui = 0;
    if (!S.next(0, cur)) return;
    f32x4 acc[2][2][4][2];
#pragma unroll
    for (int a = 0; a < 2; ++a)
#pragma unroll
        for (int b = 0; b < 2; ++b)
#pragma unroll
            for (int m = 0; m < 4; ++m)
#pragma unroll
                for (int n = 0; n < 2; ++n) acc[a][b][m][n] = (f32x4){0.f, 0.f, 0.f, 0.f};
    bf16x8 At[4][2], B0[2][2], B1[2][2];
    const char* cA = (const char*)g.A + (size_t)cur.pm * tstepA; const char* cB = (const char*)g.Bt + (size_t)cur.pn * tstep;
    S.a_ready(cur);
    if constexpr (SP2) {
        PG8_STAGE(PG8_SB(0, 0), cB, voffB); PG8_STAGE(PG8_SB(0, 1), cB + hstep, voffB); PG8_STAGE(PG8_SA(0, 0), cA, voffA); PG8_STAGE(PG8_SA(0, 1), cA + hstepA, voffA);
        if (wr == 1) PG8_BAR;
        PG8_WAIT_V(2); PG8_BAR;
        PG8_STAGE(PG8_SB(1, 0), cB + kstep, voffB); PG8_STAGE(PG8_SA(1, 0), cA + kstep, voffA); PG8_STAGE(PG8_SB(1, 1), cB + hstep + kstep, voffB);
        PG8_WAIT_V(6); PG8_BAR;
    } else {
        PG8_STAGE(PG8_SB(0, 0), cB, voffB); PG8_STAGE(PG8_SA(0, 0), cA, voffA); PG8_STAGE(PG8_SB(0, 1), cB + hstep, voffB); PG8_STAGE(PG8_SA(0, 1), cA + hstepA, voffA);
        if (wr == 1) PG8_BAR;
        PG8_WAIT_V(4); PG8_BAR;
        PG8_STAGE(PG8_SB(1, 0), cB + kstep, voffB); PG8_STAGE(PG8_SA(1, 0), cA + kstep, voffA); PG8_STAGE(PG8_SB(1, 1), cB + hstep + kstep, voffB);
        PG8_WAIT_V(6); PG8_BAR;
    }
    for (;;) {
        const bool has_next = S.next(ui + 1, nxt);
        const char* nA = has_next ? (const char*)g.A + (size_t)nxt.pm * tstepA : cA; const char* nB = has_next ? (const char*)g.Bt + (size_t)nxt.pn * tstep : cB;
        for (int t = 0; t < nt; t += 2) {
            const bool last = (t == nt - 2);
            const char* a1 = cA + (size_t)(t + 1) * kstep;
            const char* a2 = last ? nA : cA + (size_t)(t + 2) * kstep; const char* b2 = last ? nB : cB + (size_t)(t + 2) * kstep;
            const char* a3 = a2 + kstep; const char* b3 = b2 + kstep;
            if (last && has_next) S.a_ready(nxt);
            if constexpr (SP2) {
            PG8_LDB(B0, 0, 0); PG8_LDB(B1, 0, 1); PG8_SCHED; PG8_LDA(At, 0, 0); PG8_STAGE(PG8_SA(1, 1), a1 + hstepA, voffA);
            PG8_WAIT_V(8); PG8_WAIT_L(0); PG8_BAR; PG8_MMA(0, 0, At, B0); PG8_MMA(0, 1, At, B1); PG8_BAR; PG8_SCHED;
            PG8_LDA(At, 0, 1); PG8_STAGE(PG8_SB(0, 0), b2, voffB); PG8_STAGE(PG8_SB(0, 1), b2 + hstep, voffB); PG8_STAGE(PG8_SA(0, 0), a2, voffA);
            PG8_WAIT_V(8); PG8_WAIT_L(0); PG8_BAR; PG8_MMA(1, 0, At, B0); PG8_MMA(1, 1, At, B1); PG8_BAR; PG8_SCHED;
            PG8_LDB(B0, 1, 0); PG8_LDB(B1, 1, 1); PG8_SCHED; PG8_LDA(At, 1, 0); PG8_STAGE(PG8_SA(0, 1), a2 + hstepA, voffA);
            PG8_WAIT_V(8); PG8_WAIT_L(0); PG8_BAR; PG8_MMA(0, 0, At, B0); PG8_MMA(0, 1, At, B1); PG8_BAR; PG8_SCHED;
            PG8_LDA(At, 1, 1); PG8_STAGE(PG8_SB(1, 0), b3, voffB); PG8_STAGE(PG8_SB(1, 1), b3 + hstep, voffB); PG8_STAGE(PG8_SA(1, 0), a3, voffA);
            PG8_WAIT_V(8); PG8_WAIT_L(0); PG8_BAR; PG8_MMA(1, 0, At, B0); PG8_MMA(1, 1, At, B1); PG8_BAR; PG8_SCHED;
            } else {
            PG8_LDB(B0, 0, 0); PG8_SCHED; PG8_LDA(At, 0, 0); PG8_STAGE(PG8_SA(1, 1), a1 + hstepA, voffA);
            PG8_WAIT_L(8); PG8_BAR; PG8_WAIT_L(0); PG8_MMA(0, 0, At, B0); PG8_BAR; PG8_SCHED;
            PG8_LDB(B1, 0, 1); PG8_STAGE(PG8_SB(0, 0), b2, voffB);
            PG8_BAR; PG8_WAIT_L(0); PG8_MMA(0, 1, At, B1); PG8_BAR;
            PG8_LDA(At, 0, 1); PG8_STAGE(PG8_SA(0, 0), a2, voffA);
            PG8_BAR; PG8_WAIT_L(0); PG8_MMA(1, 0, At, B0); PG8_BAR; PG8_SCHED;
            PG8_STAGE(PG8_SB(0, 1), b2 + hstep, voffB);
            PG8_WAIT_V(6); PG8_BAR; PG8_MMA(1, 1, At, B1); PG8_BAR;
            PG8_LDB(B0, 1, 0); PG8_SCHED; PG8_LDA(At, 1, 0); PG8_STAGE(PG8_SA(0, 1), a2 + hstepA, voffA);
            PG8_WAIT_L(8); PG8_BAR; PG8_WAIT_L(0); PG8_MMA(0, 0, At, B0); PG8_BAR; PG8_SCHED;
            PG8_LDB(B1, 1, 1); PG8_STAGE(PG8_SB(1, 0), b3, voffB);
            PG8_BAR; PG8_WAIT_L(0); PG8_MMA(0, 1, At, B1); PG8_BAR;
            PG8_LDA(At, 1, 1); PG8_STAGE(PG8_SA(1, 0), a3, voffA);
            PG8_BAR; PG8_WAIT_L(0); PG8_MMA(1, 0, At, B0); PG8_BAR; PG8_SCHED;
            PG8_STAGE(PG8_SB(1, 1), b3 + hstep, voffB);
            PG8_WAIT_V(6); PG8_BAR; PG8_MMA(1, 1, At, B1); PG8_BAR;
            }
        }
        if constexpr (ALIGN_EPI) { if (wr == 0) PG8_BAR; }
        if constexpr (!Epi::AFTER_DRAIN) { E(acc, cur, wr, wc, fr, fq); S.done(cur); }
        if (!has_next) break;
#pragma unroll
        for (int a = 0; a < 2; ++a)
#pragma unroll
            for (int b = 0; b < 2; ++b)
#pragma unroll
                for (int m = 0; m < 4; ++m)
#pragma unroll
                    for (int n = 0; n < 2; ++n) acc[a][b][m][n] = (f32x4){0.f, 0.f, 0.f, 0.f};
        cur = nxt; cA = nA; cB = nB; ++ui;
        if constexpr (ALIGN_EPI) { if (wr == 1) PG8_BAR; }
    }
    PG8_WAIT_V(0);
    if constexpr (!ALIGN_EPI) { if (wr == 0) PG8_BAR; }
    PG8_BAR;
    if constexpr (Epi::AFTER_DRAIN) { E.fused(acc, cur, wr, wc, fr, fq, lds, wid, lane); S.done(cur); }
#undef PG8_SA
#undef PG8_SB
#undef PG8_STAGE
#undef PG8_LDA
#undef PG8_LDB
#undef PG8_MMA
#undef PG8_WAIT_V
#undef PG8_WAIT_L
#undef PG8_BAR
#undef PG8_SCHED
}
}


struct EpiF32 {
  static constexpr bool PERM = false, AFTER_DRAIN = false;
  bf16_t* OUT;
  __device__ __forceinline__ void operator()(const pg8::f32x4 (&acc)[2][2][4][2], const pg8::Unit& u, int wr, int wc, int fr, int fq) const {
#pragma unroll
    for (int ai = 0; ai < 2; ++ai)
#pragma unroll
      for (int m = 0; m < 4; ++m) {
        bf16_t* rp = OUT + (size_t)(u.pm * 256 + ai * 128 + wr * 64 + m * 16 + fr) * 1024 + u.pn * 256 + wc * 32 + 4 * fq;
#pragma unroll
        for (int bj = 0; bj < 2; ++bj)
#pragma unroll
          for (int n = 0; n < 2; ++n) { const pg8::f32x4 v = acc[ai][bj][m][n]; u32x2 w; w[0] = cvtpk(v[0], v[1]); w[1] = cvtpk(v[2], v[3]); *(u32x2*)(rp + bj * 128 + n * 16) = w; }
      }
  }
};
struct EpiSwiGLU {
  static constexpr bool PERM = false, AFTER_DRAIN = false;
  bf16_t* TT; const float* RS;
  __device__ __forceinline__ void operator()(const pg8::f32x4 (&acc)[2][2][4][2], const pg8::Unit& u, int wr, int wc, int fr, int fq) const {
#pragma unroll
    for (int ai = 0; ai < 2; ++ai)
#pragma unroll
      for (int m = 0; m < 4; ++m) {
        const int row = u.pm * 256 + ai * 128 + wr * 64 + m * 16 + fr; const float rs = RS[row];
        bf16_t* rp = TT + (size_t)row * DFF + u.pn * 128 + wc * 32 + 4 * fq;
#pragma unroll
        for (int n = 0; n < 2; ++n) {
          const pg8::f32x4 g = acc[ai][0][m][n] * rs, uu = acc[ai][1][m][n] * rs;
          u32x2 w; w[0] = cvtpk(g[0] * sigm(g[0]) * uu[0], g[1] * sigm(g[1]) * uu[1]); w[1] = cvtpk(g[2] * sigm(g[2]) * uu[2], g[3] * sigm(g[3]) * uu[3]);
          *(u32x2*)(rp + n * 16) = w;
        }
      }
  }
};
struct EpiIn {
  static constexpr bool PERM = true, AFTER_DRAIN = false;
  bf16_t* PROJ; bf16_t* KM; const float2* R64; const float2* R128; const float* RS; int seqmask;
  __device__ __forceinline__ void operator()(const pg8::f32x4 (&acc)[2][2][4][2], const pg8::Unit& u, int wr, int wc, int fr, int fq) const {
#pragma unroll
    for (int bj = 0; bj < 2; ++bj) {
      const int cb = u.pn * 256 + bj * 128 + wc * 32;
      if (cb >= C_END) continue;
      const int kind = cb < C_CQL ? 0 : ((cb < C_KR || (cb >= C_VV && cb < C_G)) ? 1 : (cb < C_Q ? 2 : (cb < C_VV ? 3 : 4)));
      const int c0 = cb + 8 * fq;
#pragma unroll
      for (int ai = 0; ai < 2; ++ai)
#pragma unroll
        for (int m = 0; m < 4; ++m) {
          const int row = u.pm * 256 + ai * 128 + wr * 64 + m * 16 + fr; const float rs = RS[row]; const int pos = row & seqmask;
          u32x4 w;
#pragma unroll
          for (int n = 0; n < 2; ++n) {
            pg8::f32x4 v = acc[ai][bj][m][n] * rs;
            if (kind == 0) { v[0] = gelu_t(v[0]); v[1] = gelu_t(v[1]); v[2] = gelu_t(v[2]); v[3] = gelu_t(v[3]); }
            else if (kind == 4) { v[0] = sigm(v[0]); v[1] = sigm(v[1]); v[2] = sigm(v[2]); v[3] = sigm(v[3]); }
            else if (kind == 3 || kind == 2) {
              const pg8::f32x4 cs = kind == 3 ? *(const pg8::f32x4*)(R128 + pos * 64 + ((((c0 + 4 * n) - C_Q) & 127) >> 1))
                                              : *(const pg8::f32x4*)(R64 + pos * 32 + (((c0 + 4 * n) - C_KR) >> 1));
              const float a0 = v[0] * cs[0] - v[1] * cs[1], a1 = v[1] * cs[0] + v[0] * cs[1], a2 = v[2] * cs[2] - v[3] * cs[3], a3 = v[3] * cs[2] + v[2] * cs[3];
              v[0] = a0; v[1] = a1; v[2] = a2; v[3] = a3;
            }
            w[2 * n] = cvtpk(v[0], v[1]); w[2 * n + 1] = cvtpk(v[2], v[3]);
          }
          if (kind == 2) {
#pragma unroll
            for (int h = 0; h < 8; ++h) *(u32x4*)(KM + (size_t)row * 1536 + h * 192 + 128 + (c0 - C_KR)) = w;
          } else *(u32x4*)(PROJ + (size_t)row * INP + c0) = w;
        }
    }
  }
};

template <int STEP> struct EpiGate {
  static constexpr bool PERM = false, AFTER_DRAIN = false;
  const bf16_t* G; float* MACC; bf16_t* OUT;
  __device__ __forceinline__ void operator()(const pg8::f32x4 (&acc)[2][2][4][2], const pg8::Unit& u, int wr, int wc, int fr, int fq) const {
#pragma unroll
    for (int ai = 0; ai < 2; ++ai)
#pragma unroll
      for (int m = 0; m < 4; ++m) {
        const int row = u.pm * 256 + ai * 128 + wr * 64 + m * 16 + fr; const int c0 = u.pn * 256 + wc * 32 + 4 * fq;
#pragma unroll
        for (int bj = 0; bj < 2; ++bj)
#pragma unroll
          for (int n = 0; n < 2; ++n) {
            const int c = c0 + bj * 128 + n * 16;
            const u32x2 gw = *(const u32x2*)(G + (size_t)row * INP + c);
            pg8::f32x4 v = acc[ai][bj][m][n];
            v[0] *= bflo(gw[0]); v[1] *= bfhi(gw[0]); v[2] *= bflo(gw[1]); v[3] *= bfhi(gw[1]);
            float* mp = MACC + (size_t)row * 1024 + c;
            if (STEP > 0) v += *(const pg8::f32x4*)mp;
            if (STEP < 2) *(pg8::f32x4*)mp = v;
            else { u32x2 w; w[0] = cvtpk(v[0], v[1]); w[1] = cvtpk(v[2], v[3]); *(u32x2*)(OUT + (size_t)row * 1024 + c) = w; }
          }
      }
  }
};

#define LAS __attribute__((address_space(3)))
#define XB_TMO      128
#define XB_XCNT(j)  (256  + 64 * (j))
#define XB_XSUB(j)  (1280 + 64 * (j))
#define XB_XGEN(j)  (2304 + 64 * (j))
#define XB_TOP      3328
#define XB_TOPGEN   3392
#define XCD_BAR_WORDS 3456
#define XB_SPIN_CAP (1u << 22)

__device__ __forceinline__ unsigned xb_ld(unsigned* p)              { return __hip_atomic_load(p, __ATOMIC_RELAXED, __HIP_MEMORY_SCOPE_AGENT); }
__device__ __forceinline__ unsigned xb_add(unsigned* p, unsigned v) { return __hip_atomic_fetch_add(p, v, __ATOMIC_RELAXED, __HIP_MEMORY_SCOPE_AGENT); }
__device__ __forceinline__ unsigned xb_xcc_id() { return (unsigned)__builtin_amdgcn_s_getreg((3 << 11) | 20) & 0xFu; }
#define XB_SPIN(cond, bar) do { unsigned _sp = 0; while (cond) { __builtin_amdgcn_s_sleep(1); \
    if ((++_sp & 255u) == 0u) { if (xb_ld(&(bar)[XB_TMO])) break; if (_sp > XB_SPIN_CAP) { atomicAdd(&(bar)[XB_TMO], 1u); break; } } } } while (0)

struct XcdBarrier {
    unsigned* bar; unsigned x;
    volatile LAS unsigned* st;
};

__device__ __forceinline__ XcdBarrier xcd_barrier_post(unsigned* bar, volatile LAS unsigned* st) {
    XcdBarrier b; b.bar = bar; b.x = xb_xcc_id(); b.st = st;
    if (threadIdx.x == 0) (void)xb_add(&bar[XB_XCNT(b.x)], 1u);
    return b;
}
__device__ __forceinline__ void xcd_barrier_complete(unsigned* bar, unsigned x, unsigned& nloc, unsigned& nx) {
    const unsigned G = gridDim.x * gridDim.y * gridDim.z;
    unsigned sum, cnt, mine, sp = 0u;
    for (;;) {
        sum = 0u; cnt = 0u; mine = 0u;
#pragma unroll
        for (unsigned j = 0; j < 16; ++j) { const unsigned c = xb_ld(&bar[XB_XCNT(j)]); sum += c; cnt += (c > 0u) ? 1u : 0u; mine = (j == x) ? c : mine; }
        if (sum == G) break;
        __builtin_amdgcn_s_sleep(1);
        if ((++sp & 255u) == 0u) { if (xb_ld(&bar[XB_TMO])) break; if (sp > XB_SPIN_CAP) { atomicAdd(&bar[XB_TMO], 1u); break; } }
    }
    nloc = mine > 0u ? mine : 1u; nx = cnt > 0u ? cnt : 1u;
}

__device__ __forceinline__ void xcd_barrier(const XcdBarrier& b) {
    asm volatile("s_waitcnt vmcnt(0)" ::: "memory");
    __syncthreads();
    if (threadIdx.x == 0) {
        unsigned* bar = b.bar;
        __builtin_amdgcn_s_waitcnt(0);
        unsigned nloc = b.st[0], nx = b.st[1];
        if (nloc == 0u) { xcd_barrier_complete(bar, b.x, nloc, nx); b.st[0] = nloc; b.st[1] = nx; }
        const unsigned old = xb_add(&bar[XB_XSUB(b.x)], 1u);
        const unsigned gen = old / nloc;
        if (old + 1u == (gen + 1u) * nloc) {
            __builtin_amdgcn_fence(__ATOMIC_RELEASE, "agent");
            asm volatile("s_waitcnt vmcnt(0)" ::: "memory");
            const unsigned og = xb_add(&bar[XB_TOP], 1u);
            const unsigned tg = og / nx;
            if (og + 1u == (tg + 1u) * nx) xb_add(&bar[XB_TOPGEN], 1u);
            else XB_SPIN(xb_ld(&bar[XB_TOPGEN]) == tg, bar);
            __builtin_amdgcn_fence(__ATOMIC_ACQUIRE, "agent");
            xb_add(&bar[XB_XGEN(b.x)], 1u);
            asm volatile("s_waitcnt vmcnt(0)" ::: "memory");
        } else {
            XB_SPIN(xb_ld(&bar[XB_XGEN(b.x)]) == gen, bar);
            __builtin_amdgcn_fence(__ATOMIC_ACQUIRE, "agent");
            asm volatile("s_waitcnt vmcnt(0)" ::: "memory");
        }
    }
    __syncthreads();
}


DEV void tile_map(int u, int nM, int nN, int& pm, int& pn) {
  const int x = u & 7, t = u >> 3, ML = nM >> 3, per = 4 * nN;
  const int band = t / per, idx = t - band * per;
  pm = x * ML + band * 4 + (idx & 3); pn = idx >> 2;
}

#define TIDX() const int tid = ltid(), lane = tid & 63, wid = tid >> 6, r32 = lane & 31, hi = lane >> 5, wm = wid & 3, wn = wid >> 2; (void)lane; (void)wid; (void)r32; (void)hi; (void)wm; (void)wn
#define GTID() const int gtid = bid * NTHR + ltid(), gsz = nblk * NTHR
DEV void run_phase(const Params& p, const int grp, const int l, const int ph, char* lds) {
  const int nblk = gridDim.x, bid = blockIdx.x;
  char* ws = p.ws;
  float2* R128 = (float2*)(ws + O_R128); float2* R64 = (float2*)(ws + O_R64); float* RS1 = (float*)(ws + O_RS1); float* RS2 = (float*)(ws + O_RS2);
  bf16_t* HN = (bf16_t*)(ws + O_HN); bf16_t* PROJ = (bf16_t*)(ws + O_PROJ); bf16_t* QM = (bf16_t*)(ws + O_QM); bf16_t* KM = (bf16_t*)(ws + O_KM);
  bf16_t* VM = (bf16_t*)(ws + O_VM); bf16_t* YB = (bf16_t*)(ws + O_YB);
  bf16_t* MERGED = (bf16_t*)(ws + O_MERGED); bf16_t* MIX = (bf16_t*)(ws + O_MIX); bf16_t* H2 = (bf16_t*)(ws + O_H2); bf16_t* TT = (bf16_t*)(ws + O_TT); bf16_t* FF = (bf16_t*)(ws + O_FF);

  const int T = grp < 2 ? 32768 : 16384, seqlen = grp < 2 ? 8192 : 4096, nseq = 4;
  const float* xin0 = grp < 2 ? p.in[0] + (size_t)grp * 32768 * 1024 : p.in[1];
  float* xout = p.out + (size_t)(grp < 2 ? grp * 32768 : 65536) * 1024;
  const char* wl = ws + (size_t)l * WL;
  const float* xres = l == 0 ? xin0 : xout;
  if (ph == 0) {
  { GTID();
  for (int l = 0; l < 2; ++l) {
    char* wl = ws + (size_t)l * WL;
    prep_w<MAP_IN>((bf16_t*)(wl + O_WIN), INP, 1024, p.in[3] + (size_t)l * 1024 * 7360, nullptr, 7360, p.in[2] + l * 1024, gtid, gsz);
    prep_w<MAP_UQ>((bf16_t*)(wl + O_WUQ), 1536, 384, p.in[9] + (size_t)l * 384 * 1536, nullptr, 1536, p.in[8] + l * 384, gtid, gsz);
    prep_w<MAP_ID>((bf16_t*)(wl + O_WUKV), 2048, 256, p.in[11] + (size_t)l * 256 * 2048, nullptr, 2048, p.in[10] + l * 256, gtid, gsz);
    prep_w<MAP_ID>((bf16_t*)(wl + O_WPA), 1024, 1024, p.in[13] + (size_t)l * 1024 * 1024, nullptr, 1024, nullptr, gtid, gsz);
    prep_w<MAP_ID>((bf16_t*)(wl + O_WPB), 1024, 1024, p.in[14] + (size_t)l * 1024 * 1024, nullptr, 1024, nullptr, gtid, gsz);
    prep_w<MAP_ID>((bf16_t*)(wl + O_WPC), 1024, 1024, p.in[15] + (size_t)l * 1024 * 1024, nullptr, 1024, nullptr, gtid, gsz);
    prep_w<MAP_ID>((bf16_t*)(wl + O_WO), 1024, 1024, p.in[16] + (size_t)l * 1024 * 1024, nullptr, 1024, nullptr, gtid, gsz);
    prep_w<MAP_GU>((bf16_t*)(wl + O_WGU), 5632, 1024, p.in[19] + (size_t)l * 1024 * DFF, p.in[20] + (size_t)l * 1024 * DFF, DFF, p.in[18] + l * 1024, gtid, gsz);
    prep_w<MAP_ID>((bf16_t*)(wl + O_WD), 1024, DFF, p.in[21] + (size_t)l * DFF * 1024, nullptr, 1024, nullptr, gtid, gsz);
    { bf16_t* d = (bf16_t*)(wl + O_WS); const float* s = p.in[6] + (size_t)l * 8 * 128 * 128; for (int i = gtid; i < 8 * 128 * 128; i += gsz) d[i] = f2bf(s[i]); }
  }
  for (int i = gtid; i < 8192 * 64; i += gsz) { const int pos = i >> 6, f = i & 63; double rev = (double)pos * RPP128[f]; rev -= floor(rev); const float fr = (float)rev;
    R128[i] = make_float2(__builtin_amdgcn_cosf(fr), __builtin_amdgcn_sinf(fr)); }
  for (int i = gtid; i < 8192 * 32; i += gsz) { const int pos = i >> 5, f = i & 31; double rev = (double)pos * RPP64[f]; rev -= floor(rev); const float fr = (float)rev;
    R64[i] = make_float2(__builtin_amdgcn_cosf(fr), __builtin_amdgcn_sinf(fr)); }
  }
  }
  if (ph == 0) { TIDX(); phase_cvt(p.in[0], HN, RS1, 32768, bid * 8 + wid, nblk * 8, lane); }
      if (ph == 2) {
        pg8::Gemm g{HN, (const bf16_t*)(wl + O_WIN), T, INP, 1024};
        pg8::StaticOrder so; so.init(T, INP, nblk, bid);
        EpiIn e{PROJ, KM, R64, R128, RS1, seqlen - 1};
        pg8::gemm_phase<EpiIn, pg8::StaticOrder, true, true>((PG8_LAS unsigned char*)lds, g, so, e);
      }
      if (ph == 3) {
        const int nG = T / 128, nQ = (T / 256) * 6, nKV = (T / 256) * 8, nU = nG + nQ + nKV;
        for (int u = bid; u < nU; u += nblk) {
          if (u < nG) {
#ifndef NO_GMLP
            gmlp_unit(u, PROJ, (const bf16_t*)(wl + O_WS), p.in[4] + l * 1024, p.in[5] + l * 1024, p.in[7] + l * 1024, lds);
#endif
          } else if (u < nG + nQ) {
            const int v_ = u - nG, nM = T / 256; const int m0 = (v_ % nM) * 256, n0 = (v_ / nM) * 256;
            f32x16 acc[2][4]; float ss[2];
            gemm_mainloop<2, true>(acc, ss, PROJ + (size_t)m0 * INP + C_CQL, INP, (const bf16_t*)(wl + O_WUQ) + (size_t)n0 * 384, 384, 384, lds);
            rowss_finish<2>(ss, 384, lds);
            TIDX();
            const float* rs_l = (const float*)(lds + GemmCfg<2>::RS_OFF);
#pragma unroll
            for (int mi = 0; mi < 2; ++mi) {
              const int rbl = wm * 64 + mi * 32;
#pragma unroll
              for (int nf = 0; nf < 4; ++nf) {
                const int cb = n0 + wn * 128 + nf * 32, col = cb + r32; const int jb = cb % 192;
#pragma unroll
                for (int r = 0; r < 16; ++r) {
                  const int rl = rbl + crow(r, hi); const unsigned row = (unsigned)(m0 + rl);
                  float v = acc[mi][nf][r] * rs_l[rl];
                  if (jb >= 128) {
                    const float pr = __shfl_xor(v, 1); const int j = (jb - 128) + r32; const int pos = (int)row & (seqlen - 1);
                    const float2 cs = R64[pos * 32 + (j >> 1)];
                    v = (j & 1) ? (v * cs.x + pr * cs.y) : (v * cs.x - pr * cs.y);
                  }
                  QM[row * 1536 + col] = f2bf(v);
                }
              }
            }
          } else {
            const int v_ = u - nG - nQ, nM = T / 256; const int m0 = (v_ % nM) * 256, n0 = (v_ / nM) * 256;
            f32x16 acc[2][4]; float ss[2];
            gemm_mainloop<2, true>(acc, ss, PROJ + (size_t)m0 * INP + C_CKV, INP, (const bf16_t*)(wl + O_WUKV) + (size_t)n0 * 256, 256, 256, lds);
            rowss_finish<2>(ss, 256, lds);
            TIDX();
            const float* rs_l = (const float*)(lds + GemmCfg<2>::RS_OFF);
            const int h = n0 >> 8;
#pragma unroll
            for (int mi = 0; mi < 2; ++mi) {
              const int rbl = wm * 64 + mi * 32;
#pragma unroll
              for (int nf = 0; nf < 4; ++nf) {
                const int j = nf * 32 + r32;
#pragma unroll
                for (int r = 0; r < 16; ++r) {
                  const int rl = rbl + crow(r, hi); const unsigned row = (unsigned)(m0 + rl);
                  const bf16_t ob = f2bf(acc[mi][nf][r] * rs_l[rl]);
                  if (wn == 0) KM[row * 1536 + h * 192 + j] = ob; else VM[row * 1024 + h * 128 + j] = ob;
                }
              }
            }
          }
        }
      }
      if (ph == 4) {
        const int nqb = seqlen / 256, nU = nseq * 8 * nqb;
        for (int u = bid; u < nU; u += nblk) {
          const int b = u & 255, i = u >> 8; const int y = b >> 3; const int qb = y % nqb, sub = y / nqb;
          const int sh = (b & 7) + 8 * (i * (32 / nqb) + sub); const int s = sh >> 3, h = sh & 7;
          const size_t tq = (size_t)s * seqlen + (size_t)qb * 256, tk = (size_t)s * seqlen;
#ifndef NO_MLA
          attn_unit<192, false, false>(QM + tq * 1536 + h * 192, 1536, KM + tk * 1536 + h * 192, 1536, VM + tk * 1024 + h * 128, 1024,
                                YB + tq * 1024 + h * 128, 1024, 0, seqlen / 64, qb * 256, 0.f, 0.07216878364870322f, lds);
#else
          { const int t_ = ltid(); for (int e = t_; e < 256 * 128; e += NTHR) YB[(tq + (e >> 7)) * 1024 + h * 128 + (e & 127)] = 0; (void)tk; }
#endif
        }
        const float* sinkp = p.in[12] + l * 8;
        for (int u = bid; u < nU; u += nblk) {
          const int b = u & 255, i = u >> 8; const int y = b >> 3; const int qb = y % nqb, sub = y / nqb;
          const int sh = (b & 7) + 8 * (i * (32 / nqb) + sub); const int s = sh >> 3, h = sh & 7, kvh = h >> 2;
          const size_t tq = (size_t)s * seqlen + (size_t)qb * 256, tk = (size_t)s * seqlen;
          const int q0 = qb * 256; const int kb0 = q0 - 128 < 0 ? 0 : q0 - 128; const int ke = q0 + 384 > seqlen ? seqlen : q0 + 384;
#ifndef NO_GQA
          attn_unit<128, true, true>(PROJ + tq * INP + C_Q + h * 128, INP, PROJ + tk * INP + C_K + kvh * 128, INP, PROJ + tk * INP + C_VV + kvh * 128, INP,
                               PROJ + tq * INP + C_Q + h * 128, INP, kb0, (ke - kb0) / 64, q0, sinkp[h], 0.08838834764831845f, lds);
#else
          { const int t_ = ltid(); for (int e = t_; e < 256 * 128; e += NTHR) PROJ[(tq + (e >> 7)) * INP + C_Q + h * 128 + (e & 127)] = 0; (void)tk; (void)kvh; (void)kb0; (void)ke; (void)sinkp; }
#endif
        }
      }
      if (ph == 5) {
        float* MACC = (float*)(ws + O_QM);
        pg8::StaticOrder so; so.init(T, 1024, nblk, bid);
        { pg8::Gemm g{PROJ + C_U, (const bf16_t*)(wl + O_WPA), T, 1024, 1024}; EpiGate<0> e{PROJ + C_G, MACC, MERGED};
          pg8::gemm_phase<EpiGate<0>, pg8::StaticOrder, true, true>((PG8_LAS unsigned char*)lds, g, so, e, INP); }
        { pg8::Gemm g{YB, (const bf16_t*)(wl + O_WPB), T, 1024, 1024}; EpiGate<1> e{PROJ + C_G + 1024, MACC, MERGED};
          pg8::gemm_phase<EpiGate<1>, pg8::StaticOrder, true, true>((PG8_LAS unsigned char*)lds, g, so, e, 1024); }
        { pg8::Gemm g{PROJ + C_Q, (const bf16_t*)(wl + O_WPC), T, 1024, 1024}; EpiGate<2> e{PROJ + C_G + 2048, MACC, MERGED};
          pg8::gemm_phase<EpiGate<2>, pg8::StaticOrder, true, true>((PG8_LAS unsigned char*)lds, g, so, e, INP); }
      }
      if (ph == 6) {
        pg8::Gemm g{MERGED, (const bf16_t*)(wl + O_WO), T, 1024, 1024};
        pg8::StaticOrder so; so.init(T, 1024, nblk, bid);
        EpiF32 e{MIX};
        pg8::gemm_phase<EpiF32, pg8::StaticOrder, true, true>((PG8_LAS unsigned char*)lds, g, so, e);
      }
      if (ph == 7) { TIDX(); phase_resnorm(MIX, xres, p.in[17] + l * 1024, xout, H2, RS2, T, bid * 8 + wid, nblk * 8, lane); }
      if (ph == 8) {
        pg8::Gemm g{H2, (const bf16_t*)(wl + O_WGU), T, 5632, 1024};
        pg8::StaticOrder so; so.init(T, 5632, nblk, bid);
        EpiSwiGLU e{TT, RS2};
        pg8::gemm_phase<EpiSwiGLU, pg8::StaticOrder, true, true>((PG8_LAS unsigned char*)lds, g, so, e);
      }
      if (ph == 9) {
        pg8::Gemm g{TT, (const bf16_t*)(wl + O_WD), T, 1024, DFF};
        pg8::StaticOrder so; so.init(T, 1024, nblk, bid);
        EpiF32 e{FF};
        pg8::gemm_phase<EpiF32, pg8::StaticOrder, true, true>((PG8_LAS unsigned char*)lds, g, so, e);
      }
      if (ph == 10) { TIDX(); phase_resnorm(FF, xout, p.in[22] + l * 1024, xout, l == 0 ? HN : nullptr, l == 0 ? RS1 : nullptr, T, bid * 8 + wid, nblk * 8, lane);
        if (l == 1 && grp < 2) phase_cvt(grp == 0 ? p.in[0] + (size_t)32768 * 1024 : p.in[1], HN, RS1, grp == 0 ? 32768 : 16384, bid * 8 + wid, nblk * 8, lane); }
}

#define GSYNC() xcd_barrier(xb)
__global__ void __launch_bounds__(NTHR) mega(Params p) {
  extern __shared__ __attribute__((aligned(16))) char lds[];
  cg::grid_group grid = cg::this_grid();
  volatile LAS unsigned* bst = (volatile LAS unsigned*)(lds + 151552);
  if (threadIdx.x == 0) { bst[0] = 0u; bst[1] = 0u; }
  __syncthreads();
  const XcdBarrier xb = xcd_barrier_post((unsigned*)(p.ws + O_BAR), bst);
  grid.sync();
  run_phase(p, 0, 0, 0, lds);
  GSYNC();
  for (int grp = 0; grp < 3; ++grp) {
    for (int l = 0; l < 2; ++l)
      for (int ph = 2; ph <= 10; ++ph) { run_phase(p, grp, l, ph, lds); GSYNC(); }
  }
}
__global__ void __launch_bounds__(NTHR) phase_k(Params p, int grp, int l, int ph) {
  extern __shared__ __attribute__((aligned(16))) char lds[];
  run_phase(p, grp, l, ph, lds);
}

extern "C" void kernel_launch(void* const* d_in, const int* in_sizes, int n_in, void* d_out, int out_size, void* d_ws, size_t ws_size, hipStream_t stream) {
  static int grid_blocks = 0;
  if (!grid_blocks) {
    if (ws_size < WS_END) { fprintf(stderr, "kernel_launch: ws too small %zu < %zu\n", ws_size, (size_t)WS_END); return; }
    (void)hipFuncSetAttribute((const void*)mega, hipFuncAttributeMaxDynamicSharedMemorySize, LDS_BYTES);
    (void)hipFuncSetAttribute((const void*)phase_k, hipFuncAttributeMaxDynamicSharedMemorySize, LDS_BYTES);
    int dev = 0, cus = 0, per_cu = 0;
    hipGetDevice(&dev);
    hipDeviceGetAttribute(&cus, hipDeviceAttributeMultiprocessorCount, dev);
    hipOccupancyMaxActiveBlocksPerMultiprocessor(&per_cu, mega, NTHR, LDS_BYTES);
    if (per_cu < 1) per_cu = 1;
    grid_blocks = cus;
    if (grid_blocks > 256) grid_blocks = 256;
  }
  Params p;
  memset(&p, 0, sizeof(p));
  for (int i = 0; i < 23; ++i) p.in[i] = (const float*)d_in[i];
  p.out = (float*)d_out; p.ws = (char*)d_ws;
  (void)hipMemsetAsync((char*)d_ws + O_BAR, 0, 16384, stream);
#ifdef MULTI_LAUNCH
  auto launch = [&](int grp, int l, int ph) { hipLaunchKernelGGL(phase_k, dim3(grid_blocks), dim3(NTHR), LDS_BYTES, stream, p, grp, l, ph); };
  launch(0, 0, 0);
  for (int grp = 0; grp < 3; ++grp) { for (int l = 0; l < 2; ++l) for (int ph = 2; ph <= 10; ++ph) launch(grp, l, ph); }
#else
  void* args[] = {&p};
  hipError_t e = hipLaunchCooperativeKernel((void*)mega, dim3(grid_blocks), dim3(NTHR), args, LDS_BYTES, stream);
  if (e != hipSuccess) fprintf(stderr, "cooperative launch failed: %s (grid %d)\n", hipGetErrorString(e), grid_blocks);
#endif
}
```

```cpp
#include <hip/hip_runtime.h>
#include <hip/hip_cooperative_groups.h>
#include <cstdio>
#include <cmath>
#include <cstdint>
#include <cstring>
namespace cg = cooperative_groups;

#define DEV __device__ __forceinline__
typedef unsigned short bf16_t;
typedef short bf16x8 __attribute__((ext_vector_type(8)));
typedef short s16x4 __attribute__((ext_vector_type(4)));
typedef float f32x16 __attribute__((ext_vector_type(16)));
typedef float f32x4 __attribute__((ext_vector_type(4)));
typedef unsigned u32x4 __attribute__((ext_vector_type(4)));
typedef unsigned u32x2 __attribute__((ext_vector_type(2)));

constexpr int DM = 1024, INP = 7424, DFF = 2816, TG = 32768, NTHR = 512;
constexpr int C_U = 0, C_V = 1024, C_CQL = 2048, C_CKV = 2432, C_KR = 2688, C_Q = 2752, C_K = 3776, C_VV = 4032, C_G = 4288, C_END = 7360;
constexpr float EPS = 1e-6f;
constexpr size_t SZ_WIN = (size_t)INP * 1024 * 2, SZ_WUQ = (size_t)1536 * 384 * 2, SZ_WUKV = (size_t)2048 * 256 * 2, SZ_SQ = (size_t)1024 * 1024 * 2,
                 SZ_WGU = (size_t)5632 * 1024 * 2, SZ_WD = (size_t)1024 * DFF * 2, SZ_WS = (size_t)8 * 128 * 128 * 2;
constexpr size_t O_WIN = 0, O_WUQ = O_WIN + SZ_WIN, O_WUKV = O_WUQ + SZ_WUQ, O_WPA = O_WUKV + SZ_WUKV, O_WPB = O_WPA + SZ_SQ, O_WPC = O_WPB + SZ_SQ,
                 O_WO = O_WPC + SZ_SQ, O_WGU = O_WO + SZ_SQ, O_WD = O_WGU + SZ_WGU, O_WS = O_WD + SZ_WD, WL = O_WS + SZ_WS;
constexpr size_t O_R128 = 2 * WL, O_R64 = O_R128 + (size_t)8192 * 64 * 8, O_BAR = O_R64 + (size_t)8192 * 32 * 8, O_RS1 = O_BAR + 16384,
                  O_RS2 = O_RS1 + (size_t)TG * 4, O_ACT = O_RS2 + (size_t)TG * 4;
constexpr size_t O_HN = O_ACT, O_PROJ = O_HN + (size_t)TG * 1024 * 2, O_QM = O_PROJ + (size_t)TG * INP * 2, O_KM = O_QM + (size_t)TG * 1536 * 2,
                 O_VM = O_KM + (size_t)TG * 1536 * 2, O_YB = O_VM + (size_t)TG * 1024 * 2, WS_END = O_YB + (size_t)TG * 1024 * 2;
constexpr size_t O_MERGED = O_HN, O_MIX = O_QM, O_H2 = O_VM, O_TT = O_PROJ, O_FF = O_QM;
constexpr int LDS_BYTES = 151552 + 64;
#ifndef PH_MASK
#define PH_MASK 0xFFFF
#endif
#define PH(k) constexpr ((PH_MASK >> (k)) & 1)

struct Params {
  const float* in[23];
  float* out;
  char* ws;
};
__constant__ double RPP128[64] = {0.15915494309189535, 0.13782250260398285, 0.11934937021124886, 0.10335229661843406, 0.08949940160889101, 0.07750328875537404, 0.06711508300522726, 0.05811926744187624, 0.050329212104487035, 0.04358330210530733, 0.03774158471741978, 0.032682865872357, 0.028302195830623395, 0.024508691862069852, 0.02122365276477766, 0.018378926105679667, 0.015915494309189534, 0.013782250260398287, 0.011934937021124886, 0.010335229661843406, 0.0089499401608891, 0.0077503288755374055, 0.006711508300522725, 0.005811926744187624, 0.005032921210448704, 0.004358330210530732, 0.0037741584717419768, 0.0032682865872357, 0.00283021958306234, 0.002450869186206985, 0.0021223652764777662, 0.0018378926105679669, 0.0015915494309189536, 0.0013782250260398283, 0.0011934937021124887, 0.0010335229661843407, 0.0008949940160889102, 0.0007750328875537407, 0.0006711508300522726, 0.0005811926744187624, 0.0005032921210448703, 0.0004358330210530733, 0.0003774158471741977, 0.0003268286587235699, 0.000283021958306234, 0.0002450869186206985, 0.0002122365276477766, 0.00018378926105679666, 0.00015915494309189535, 0.00013782250260398286, 0.00011934937021124885, 0.00010335229661843405, 8.949940160889102e-05, 7.750328875537406e-05, 6.711508300522727e-05, 5.811926744187624e-05, 5.0329212104487035e-05, 4.358330210530733e-05, 3.774158471741978e-05, 3.2682865872357e-05, 2.8302195830623396e-05, 2.4508691862069852e-05, 2.122365276477766e-05, 1.8378926105679668e-05};
__constant__ double RPP64[32] = {0.15915494309189535, 0.11934937021124886, 0.08949940160889101, 0.06711508300522726, 0.050329212104487035, 0.03774158471741978, 0.028302195830623395, 0.02122365276477766, 0.015915494309189534, 0.011934937021124886, 0.0089499401608891, 0.006711508300522725, 0.005032921210448704, 0.0037741584717419768, 0.00283021958306234, 0.0021223652764777662, 0.0015915494309189536, 0.0011934937021124887, 0.0008949940160889102, 0.0006711508300522726, 0.0005032921210448703, 0.0003774158471741977, 0.000283021958306234, 0.0002122365276477766, 0.00015915494309189535, 0.00011934937021124885, 8.949940160889102e-05, 6.711508300522727e-05, 5.0329212104487035e-05, 3.774158471741978e-05, 2.8302195830623396e-05, 2.122365276477766e-05};
DEV int ltid() { int t = threadIdx.x; asm volatile("" : "+v"(t)); return t; }

typedef __bf16 bf16x2_t __attribute__((ext_vector_type(2)));
typedef float f32x2 __attribute__((ext_vector_type(2)));
DEV unsigned cvtpk(float lo, float hi) { f32x2 v = {lo, hi}; bf16x2_t b = __builtin_convertvector(v, bf16x2_t); return __builtin_bit_cast(unsigned, b); }
DEV bf16_t f2bf(float x) { return (bf16_t)(cvtpk(x, 0.f) & 0xffffu); }
DEV float bf2f(bf16_t u) { return __uint_as_float(((unsigned)u) << 16); }
DEV float bflo(unsigned w) { return __uint_as_float(w << 16); }
DEV float bfhi(unsigned w) { return __uint_as_float(w & 0xffff0000u); }
DEV int crow(int r, int hi) { return (r & 3) + 8 * (r >> 2) + 4 * hi; }
DEV float gelu_t(float x) { float z = 0.7978845608f * (x + 0.044715f * x * x * x); return x * __builtin_amdgcn_rcpf(1.f + __expf(-2.f * z)); }
DEV float sigm(float x) { return __builtin_amdgcn_rcpf(1.f + __expf(-x)); }
#define SBAR() __builtin_amdgcn_sched_barrier(0)

constexpr int G_ROWB = 144;
template <int MI> struct GemmCfg { static constexpr int TM = 128 * MI, AB = TM * G_ROWB, BB = 256 * G_ROWB, STAGE = AB + BB, RS_OFF = 2 * STAGE; };

template <int MI, bool ROWSS>
DEV void gemm_mainloop(f32x16 (&acc)[MI][4], float (&ss)[MI], const bf16_t* __restrict__ A, int lda, const bf16_t* __restrict__ Bt, int ldb, int K, char* lds) {
  using C = GemmCfg<MI>;
  const int tid = ltid(), lane = tid & 63, wid = tid >> 6, r32 = lane & 31, hi = lane >> 5, wm = wid & 3, wn = wid >> 2;
  u32x4 ra[2 * MI], rb[4];
  const int prow = tid >> 3, pkc = (tid & 7) * 8;
  const bf16_t* ga = A + (size_t)prow * lda + pkc;
  const bf16_t* gb = Bt + (size_t)prow * ldb + pkc;
  const int lw = prow * G_ROWB + pkc * 2;
  const int aoff = (wm * 32 * MI + r32) * G_ROWB + hi * 16;
  const int boff = C::AB + (wn * 128 + r32) * G_ROWB + hi * 16;
#pragma unroll
  for (int mi = 0; mi < MI; ++mi) {
    ss[mi] = 0.f;
#pragma unroll
    for (int nf = 0; nf < 4; ++nf)
#pragma unroll
      for (int r = 0; r < 16; ++r) acc[mi][nf][r] = 0.f;
  }
  const int nk = K >> 6;
#define G_LOAD(kt_) do { const int k0_ = (kt_) << 6; \
    _Pragma("unroll") for (int i = 0; i < 2 * MI; ++i) ra[i] = *(const u32x4*)(ga + (size_t)i * 64 * lda + k0_); \
    _Pragma("unroll") for (int i = 0; i < 4; ++i) rb[i] = *(const u32x4*)(gb + (size_t)i * 64 * ldb + k0_); } while (0)
#define G_WRITE(s_) do { char* wb_ = lds + (s_) * C::STAGE; \
    _Pragma("unroll") for (int i = 0; i < 2 * MI; ++i) *(u32x4*)(wb_ + lw + i * 64 * G_ROWB) = ra[i]; \
    _Pragma("unroll") for (int i = 0; i < 4; ++i) *(u32x4*)(wb_ + C::AB + lw + i * 64 * G_ROWB) = rb[i]; } while (0)
  G_LOAD(0); G_WRITE(0); G_LOAD(1);
  __syncthreads();
  for (int kt = 0; kt < nk; ++kt) {
    const char* base = lds + (kt & 1) * C::STAGE;
    SBAR();
#pragma unroll
    for (int ks = 0; ks < 4; ++ks) {
      bf16x8 a[MI], b[4];
#pragma unroll
      for (int mi = 0; mi < MI; ++mi) a[mi] = *(const bf16x8*)(base + aoff + mi * 32 * G_ROWB + ks * 32);
#pragma unroll
      for (int nf = 0; nf < 4; ++nf) b[nf] = *(const bf16x8*)(base + boff + nf * 32 * G_ROWB + ks * 32);
      if (ROWSS) {
#pragma unroll
        for (int mi = 0; mi < MI; ++mi)
#pragma unroll
          for (int j = 0; j < 8; ++j) { float f = bf2f((bf16_t)a[mi][j]); ss[mi] += f * f; }
      }
      __builtin_amdgcn_s_setprio(1);
#pragma unroll
      for (int mi = 0; mi < MI; ++mi)
#pragma unroll
        for (int nf = 0; nf < 4; ++nf) acc[mi][nf] = __builtin_amdgcn_mfma_f32_32x32x16_bf16(a[mi], b[nf], acc[mi][nf], 0, 0, 0);
      __builtin_amdgcn_s_setprio(0);
    }
    SBAR();
    if (kt + 1 < nk) { G_WRITE((kt + 1) & 1); if (kt + 2 < nk) G_LOAD(kt + 2); }
    __syncthreads();
  }
#undef G_LOAD
#undef G_WRITE
}

template <int MI>
DEV void rowss_finish(float (&ss)[MI], int K, char* lds) {
  using C = GemmCfg<MI>;
  const int tid = ltid(), lane = tid & 63, wid = tid >> 6, r32 = lane & 31, hi = lane >> 5, wm = wid & 3, wn = wid >> 2;
  float* rs_l = (float*)(lds + C::RS_OFF);
#pragma unroll
  for (int mi = 0; mi < MI; ++mi) {
    float t = ss[mi] + __shfl_xor(ss[mi], 32);
    if (wn == 0 && hi == 0) rs_l[wm * 32 * MI + mi * 32 + r32] = rsqrtf(t / (float)K + EPS);
  }
  __syncthreads();
}

DEV int v_st(int k, int c) { const int kk = (k & ~0xC) | ((k & 4) << 1) | ((k & 8) >> 1); return ((kk >> 3) * 4 + (c >> 5)) * 512 + ((kk & 7) * 32 + (c & 31)) * 2; }
DEV int v_rd_base(int lane) { return ((lane & 3) << 3) | (((lane >> 2) & 3) << 6) | (((lane >> 4) & 1) << 5) | (((lane >> 5) & 1) << 8); }
constexpr int v_rd_off(int d0, int ks, int half) { return d0 * 512 + ks * 4096 + half * 2048; }
template <int OFF> DEV s16x4 tr_read(int vb) { s16x4 r; asm volatile("ds_read_b64_tr_b16 %0, %1 offset:%2" : "=&v"(r) : "v"(vb), "i"(OFF) : "memory"); return r; }
template <int D0, bool SPLIT = true> DEV void pv_one(f32x16& od, int vb, bf16x8 pa0, bf16x8 pa1, bf16x8 pa2, bf16x8 pa3) {
#define PK(L, H) (bf16x8){L[0], L[1], L[2], L[3], H[0], H[1], H[2], H[3]}
  if constexpr (SPLIT) {
  {
    const s16x4 l0 = tr_read<v_rd_off(D0, 0, 0)>(vb), h0 = tr_read<v_rd_off(D0, 0, 1)>(vb), l1 = tr_read<v_rd_off(D0, 1, 0)>(vb), h1 = tr_read<v_rd_off(D0, 1, 1)>(vb);
    asm volatile("s_waitcnt lgkmcnt(0)" ::: "memory"); SBAR();
    od = __builtin_amdgcn_mfma_f32_32x32x16_bf16(pa0, PK(l0, h0), od, 0, 0, 0);
    od = __builtin_amdgcn_mfma_f32_32x32x16_bf16(pa1, PK(l1, h1), od, 0, 0, 0);
  }
  {
    const s16x4 l2 = tr_read<v_rd_off(D0, 2, 0)>(vb), h2 = tr_read<v_rd_off(D0, 2, 1)>(vb), l3 = tr_read<v_rd_off(D0, 3, 0)>(vb), h3 = tr_read<v_rd_off(D0, 3, 1)>(vb);
    asm volatile("s_waitcnt lgkmcnt(0)" ::: "memory"); SBAR();
    od = __builtin_amdgcn_mfma_f32_32x32x16_bf16(pa2, PK(l2, h2), od, 0, 0, 0);
    od = __builtin_amdgcn_mfma_f32_32x32x16_bf16(pa3, PK(l3, h3), od, 0, 0, 0);
  }
  } else {
    const s16x4 l0 = tr_read<v_rd_off(D0, 0, 0)>(vb), h0 = tr_read<v_rd_off(D0, 0, 1)>(vb), l1 = tr_read<v_rd_off(D0, 1, 0)>(vb), h1 = tr_read<v_rd_off(D0, 1, 1)>(vb);
    const s16x4 l2 = tr_read<v_rd_off(D0, 2, 0)>(vb), h2 = tr_read<v_rd_off(D0, 2, 1)>(vb), l3 = tr_read<v_rd_off(D0, 3, 0)>(vb), h3 = tr_read<v_rd_off(D0, 3, 1)>(vb);
    asm volatile("s_waitcnt lgkmcnt(0)" ::: "memory"); SBAR();
    od = __builtin_amdgcn_mfma_f32_32x32x16_bf16(pa0, PK(l0, h0), od, 0, 0, 0);
    od = __builtin_amdgcn_mfma_f32_32x32x16_bf16(pa1, PK(l1, h1), od, 0, 0, 0);
    od = __builtin_amdgcn_mfma_f32_32x32x16_bf16(pa2, PK(l2, h2), od, 0, 0, 0);
    od = __builtin_amdgcn_mfma_f32_32x32x16_bf16(pa3, PK(l3, h3), od, 0, 0, 0);
  }
#undef PK
}
template <bool SPLIT = true> DEV void pv_d0(f32x16* o, int vb, bf16x8 pa0, bf16x8 pa1, bf16x8 pa2, bf16x8 pa3) {
  pv_one<0, SPLIT>(o[0], vb, pa0, pa1, pa2, pa3); pv_one<1, SPLIT>(o[1], vb, pa0, pa1, pa2, pa3); pv_one<2, SPLIT>(o[2], vb, pa0, pa1, pa2, pa3); pv_one<3, SPLIT>(o[3], vb, pa0, pa1, pa2, pa3);
}

template <bool WIN>
DEV void partialSM(f32x16& p0, f32x16& p1, float& m_reg, float& mn, float& alpha, const float C, const float thr_raw, int kdiff) {
  if (WIN) {
#pragma unroll
    for (int r = 0; r < 16; ++r) {
      const int d = kdiff + (r & 3) + 8 * (r >> 2);
      if (d > 128 || d < -128) p0[r] = -INFINITY;
      if (d + 32 > 128 || d + 32 < -128) p1[r] = -INFINITY;
    }
  }
  float pmax = p0[0];
#pragma unroll
  for (int r = 1; r < 16; ++r) pmax = fmaxf(pmax, p0[r]);
#pragma unroll
  for (int r = 0; r < 16; ++r) pmax = fmaxf(pmax, p1[r]);
  { auto rr = __builtin_amdgcn_permlane32_swap(__float_as_uint(pmax), __float_as_uint(pmax), false, false);
    pmax = fmaxf(__uint_as_float(rr[0]), __uint_as_float(rr[1])); }
  if (__builtin_expect(__all(pmax - m_reg <= thr_raw), 1)) { mn = m_reg; alpha = 1.f; }
  else { mn = fmaxf(m_reg, pmax); alpha = __builtin_amdgcn_exp2f((m_reg - mn) * C); m_reg = mn; }
  const float mnC = -mn * C;
#pragma unroll
  for (int r = 0; r < 16; ++r) p0[r] = fmaf(p0[r], C, mnC);
#pragma unroll
  for (int r = 0; r < 16; ++r) p1[r] = fmaf(p1[r], C, mnC);
#pragma unroll
  for (int r = 0; r < 16; ++r) p0[r] = __builtin_amdgcn_exp2f(p0[r]);
}
DEV void finishSM(f32x16& p0, f32x16& p1, float alpha, float& l_reg, bf16x8& pa0, bf16x8& pa1, bf16x8& pa2, bf16x8& pa3) {
#pragma unroll
  for (int r = 0; r < 16; ++r) p1[r] = __builtin_amdgcn_exp2f(p1[r]);
  float ps = 0;
#pragma unroll
  for (int r = 0; r < 16; ++r) ps += p0[r];
#pragma unroll
  for (int r = 0; r < 16; ++r) ps += p1[r];
  { auto rr = __builtin_amdgcn_permlane32_swap(__float_as_uint(ps), __float_as_uint(ps), false, false);
    ps = __uint_as_float(rr[0]) + __uint_as_float(rr[1]); }
  l_reg = l_reg * alpha + ps;
#define PK4(P, BASE, OUT) do { unsigned a0 = cvtpk(P[BASE + 0], P[BASE + 1]), a1 = cvtpk(P[BASE + 2], P[BASE + 3]);   \
    unsigned b0 = cvtpk(P[BASE + 4], P[BASE + 5]), b1 = cvtpk(P[BASE + 6], P[BASE + 7]);                              \
    auto r0 = __builtin_amdgcn_permlane32_swap(a0, b0, false, false); auto r1 = __builtin_amdgcn_permlane32_swap(a1, b1, false, false); \
    u32x4 w = {r0[0], r1[0], r0[1], r1[1]}; OUT = *reinterpret_cast<bf16x8*>(&w); } while (0)
  PK4(p0, 0, pa0); PK4(p0, 8, pa1); PK4(p1, 0, pa2); PK4(p1, 8, pa3);
#undef PK4
}

template <int DQK> struct ACfg { static constexpr int KROW = DQK * 2 + 16, KT = 64 * KROW, NKP = (64 * (DQK / 8)) / NTHR, PPR = DQK / 8; };

template <int DQK, int NQR>
DEV void qkt(f32x16& p0, f32x16& p1, const char* Ks, const bf16x8* qr, const char* qlds_, int r32, int hi) {
  constexpr int KROW = ACfg<DQK>::KROW;
  unsigned qa = (unsigned)(uintptr_t)qlds_; asm volatile("" : "+v"(qa));
  const __attribute__((address_space(3))) char* qlds = (const __attribute__((address_space(3))) char*)qa;
#pragma unroll
  for (int r = 0; r < 16; ++r) { p0[r] = 0.f; p1[r] = 0.f; }
#pragma unroll
  for (int d0 = 0; d0 < DQK / 16; ++d0) {
    const int cb = (d0 * 16 + hi * 8) * 2;
    bf16x8 b0 = *reinterpret_cast<const bf16x8*>(Ks + r32 * KROW + cb);
    bf16x8 b1 = *reinterpret_cast<const bf16x8*>(Ks + (32 + r32) * KROW + cb);
    bf16x8 q;
    if (d0 < NQR) q = qr[d0 < NQR ? d0 : 0]; else q = *reinterpret_cast<const __attribute__((address_space(3))) bf16x8*>(qlds + (d0 - NQR) * 1024);
    p0 = __builtin_amdgcn_mfma_f32_32x32x16_bf16(b0, q, p0, 0, 0, 0);
    p1 = __builtin_amdgcn_mfma_f32_32x32x16_bf16(b1, q, p1, 0, 0, 0);
    if (NQR < DQK / 16 && (d0 & 3) == 3) SBAR();
  }
}

template <int DQK, bool WIN, bool TWO>
DEV void attn_unit(const bf16_t* Qb, int ldq, const bf16_t* __restrict__ Kh, int ldk, const bf16_t* __restrict__ Vh, int ldv,
                   bf16_t* Ob, int ldo, int kbeg, int NT, int q0, float sink, const float SCALE, char* lds) {
  using CF = ACfg<DQK>;
  constexpr int KROW = CF::KROW, KT = CF::KT, NKP = CF::NKP, PPR = CF::PPR, SHM_V = 16384;
  const float C = SCALE * 1.4426950408889634f, thr_raw = 8.f / SCALE;
  const int tid = ltid(), wid = tid >> 6, lane = tid & 63, r32 = lane & 31, hi = lane >> 5;
  char* V_lds = lds; char* K_lds = lds + 2 * SHM_V;
  float* wsf = (float*)(lds + 2 * SHM_V + 2 * KT) + wid * 64; float* li_l = wsf; float* al_l = wsf + 32;
  float m_reg = -1e30f, l_reg = 0;
  f32x16 o[4];
#pragma unroll
  for (int d = 0; d < 4; ++d)
#pragma unroll
    for (int r = 0; r < 16; ++r) o[d][r] = 0.f;
  constexpr int NQR = TWO ? 4 : DQK / 16;
  bf16x8 qr[NQR];
  const bf16_t* Qw = Qb + (size_t)(wid * 32 + r32) * ldq + hi * 8;
  char* qlds = lds + 2 * SHM_V + 2 * KT + 2048 + wid * 8192 + lane * 16;
#pragma unroll
  for (int d0 = 0; d0 < NQR; ++d0) qr[d0] = *(const bf16x8*)(Qw + d0 * 16);
#pragma unroll
  for (int d0 = NQR; d0 < DQK / 16; ++d0) *(bf16x8*)(qlds + (d0 - NQR) * 1024) = *(const bf16x8*)(Qw + d0 * 16);
  const int sr = tid >> 4, sc = (tid & 15) * 8, vst0 = v_st(sr, sc), vst1 = v_st(32 + sr, sc);
  const int vb0 = (int)(uintptr_t)V_lds + v_rd_base(lane);
  const unsigned voff = (unsigned)(sr * ldv + sc) * 2u, vstep = (unsigned)ldv * 64u;
  unsigned koff[NKP]; int klds[NKP];
#pragma unroll
  for (int i = 0; i < NKP; ++i) { const int p = tid + i * NTHR; const int kr = p / PPR, kc = (p % PPR) * 8; koff[i] = (unsigned)(kr * ldk + kc) * 2u; klds[i] = kr * KROW + kc * 2; }
  const int qpos = q0 + wid * 32 + r32;
  bf16x8 svs0, svs1, sks[NKP];
#define SLOAD(k0) do { const char* Vt_ = (const char*)(Vh + (size_t)(k0) * ldv); const char* Kt_ = (const char*)(Kh + (size_t)(k0) * ldk); \
    svs0 = *(const bf16x8*)(Vt_ + voff); svs1 = *(const bf16x8*)(Vt_ + vstep + voff); \
    _Pragma("unroll") for (int i_ = 0; i_ < NKP; ++i_) sks[i_] = *(const bf16x8*)(Kt_ + koff[i_]); } while (0)
#define SWRITE(b) do { *(bf16x8*)(V_lds + (b) * SHM_V + vst0) = svs0; *(bf16x8*)(V_lds + (b) * SHM_V + vst1) = svs1; \
    _Pragma("unroll") for (int i_ = 0; i_ < NKP; ++i_) *(bf16x8*)(K_lds + (b) * KT + klds[i_]) = sks[i_]; } while (0)
#define SWAIT() asm volatile("s_waitcnt vmcnt(0)" ::: "memory")
#define RESC(a) do { if (__any((a) < 1.f)) { if (hi == 0) al_l[r32] = (a); asm volatile("s_waitcnt lgkmcnt(0)" ::: "memory"); \
    _Pragma("unroll") for (int d = 0; d < 4; ++d) _Pragma("unroll") for (int r = 0; r < 16; ++r) o[d][r] *= al_l[crow(r, hi)]; } } while (0)
#define KDIFF(t) (kbeg + (t) * 64 + 4 * hi - qpos)
  bf16x8 pa0, pa1, pa2, pa3;
  if constexpr (TWO) {
  f32x16 pA0, pA1, pB0, pB1; float mnA, mnB, alA, alB;
  SLOAD(kbeg); SWAIT(); SWRITE(0); SLOAD(kbeg + 64); __syncthreads();
  qkt<DQK, NQR>(pA0, pA1, K_lds, qr, qlds, r32, hi); partialSM<WIN>(pA0, pA1, m_reg, mnA, alA, C, thr_raw, KDIFF(0));
  SWAIT(); SWRITE(1); __syncthreads();
  for (int j = 1; j + 1 < NT; j += 2) {
    SBAR(); qkt<DQK, NQR>(pB0, pB1, K_lds + KT, qr, qlds, r32, hi);
    finishSM(pA0, pA1, alA, l_reg, pa0, pa1, pa2, pa3); SBAR();
    SLOAD(kbeg + (j + 1) * 64); SBAR();
    pv_d0(o, vb0, pa0, pa1, pa2, pa3); partialSM<WIN>(pB0, pB1, m_reg, mnB, alB, C, thr_raw, KDIFF(j));
    __syncthreads(); SWAIT(); SWRITE(0);
    RESC(alB); __syncthreads();
    SBAR(); qkt<DQK, NQR>(pA0, pA1, K_lds, qr, qlds, r32, hi);
    finishSM(pB0, pB1, alB, l_reg, pa0, pa1, pa2, pa3); SBAR();
    SLOAD(kbeg + (j + 2) * 64); SBAR();
    pv_d0(o, vb0 + SHM_V, pa0, pa1, pa2, pa3); partialSM<WIN>(pA0, pA1, m_reg, mnA, alA, C, thr_raw, KDIFF(j + 1));
    __syncthreads(); SWAIT(); SWRITE(1);
    RESC(alA); __syncthreads();
  }
  SBAR(); qkt<DQK, NQR>(pB0, pB1, K_lds + KT, qr, qlds, r32, hi);
  finishSM(pA0, pA1, alA, l_reg, pa0, pa1, pa2, pa3); SBAR();
  pv_d0(o, vb0, pa0, pa1, pa2, pa3); partialSM<WIN>(pB0, pB1, m_reg, mnB, alB, C, thr_raw, KDIFF(NT - 1));
  __syncthreads(); RESC(alB);
  finishSM(pB0, pB1, alB, l_reg, pa0, pa1, pa2, pa3); SBAR();
  pv_d0(o, vb0 + SHM_V, pa0, pa1, pa2, pa3);
  } else {
  f32x16 pA0, pA1; float mnA, alA;
  SLOAD(kbeg); SWAIT(); SWRITE(0); __syncthreads();
  for (int j = 0; j < NT; ++j) {
    const int bf = j & 1;
    if (j + 1 < NT) SLOAD(kbeg + (j + 1) * 64);
    SBAR(); qkt<DQK, NQR>(pA0, pA1, K_lds + bf * KT, qr, qlds, r32, hi);
    partialSM<WIN>(pA0, pA1, m_reg, mnA, alA, C, thr_raw, KDIFF(j));
    RESC(alA);
    finishSM(pA0, pA1, alA, l_reg, pa0, pa1, pa2, pa3); SBAR();
    if (j + 1 < NT) { SWAIT(); if (bf) SWRITE(0); else SWRITE(1); }
    SBAR();
    pv_d0<false>(o, vb0 + bf * SHM_V, pa0, pa1, pa2, pa3);
    __syncthreads();
  }
  }
  if (WIN) l_reg += __builtin_amdgcn_exp2f(sink * 1.4426950408889634f - m_reg * C);
  if (hi == 0) li_l[r32] = l_reg; asm volatile("s_waitcnt lgkmcnt(0)" ::: "memory");
  const unsigned obase = (unsigned)((wid * 32 + 4 * hi) * ldo + r32) * 2u;
#pragma unroll
  for (int r = 0; r < 16; ++r) {
    const int dr = (r & 3) + 8 * (r >> 2); const float rl = __builtin_amdgcn_rcpf(li_l[dr + 4 * hi]);
    char* op = (char*)Ob + (obase + (unsigned)(dr * ldo) * 2u);
#pragma unroll
    for (int d0 = 0; d0 < 4; ++d0) *(bf16_t*)(op + d0 * 64) = f2bf(o[d0][r] * rl);
  }
  __syncthreads();
#undef SLOAD
#undef SWRITE
#undef SWAIT
#undef RESC
#undef KDIFF
}

DEV void gmlp_unit(int chunk, bf16_t* PROJ, const bf16_t* WSs, const float* __restrict__ ln_g, const float* __restrict__ ln_b, const float* __restrict__ b_s, char* lds) {
  const int tid = ltid(), wid = tid >> 6, lane = tid & 63, r32 = lane & 31, hi = lane >> 5;
  float* stats = (float*)(lds + 65536);
  const size_t t0 = (size_t)chunk * 128;
  for (int rb = 0; rb < 16; rb += 4) {
    u32x4 x0[4], x1[4]; float sj[4], qj[4];
#pragma unroll
    for (int j = 0; j < 4; ++j) { const bf16_t* vp = PROJ + (t0 + wid * 16 + rb + j) * INP + C_V; x0[j] = *(const u32x4*)(vp + lane * 8); x1[j] = *(const u32x4*)(vp + 512 + lane * 8); }
#pragma unroll
    for (int j = 0; j < 4; ++j) { float s = 0.f, q = 0.f;
#pragma unroll
      for (int i = 0; i < 4; ++i) { float a = bflo(x0[j][i]), b2 = bfhi(x0[j][i]), c = bflo(x1[j][i]), d = bfhi(x1[j][i]); s += (a + b2) + (c + d); q += (a * a + b2 * b2) + (c * c + d * d); }
      sj[j] = s; qj[j] = q; }
#pragma unroll
    for (int off = 32; off > 0; off >>= 1)
#pragma unroll
      for (int j = 0; j < 4; ++j) { sj[j] += __shfl_xor(sj[j], off); qj[j] += __shfl_xor(qj[j], off); }
    if (lane == 0) {
#pragma unroll
      for (int j = 0; j < 4; ++j) { const int row = wid * 16 + rb + j; const float mean = sj[j] * (1.f / 1024.f); const float var = fmaxf(qj[j] * (1.f / 1024.f) - mean * mean, 0.f); stats[row * 2] = mean; stats[row * 2 + 1] = rsqrtf(var + EPS); }
    }
  }
  __syncthreads();
  const int mi = wid & 3, wc = wid >> 2;
  const int vb = (int)(uintptr_t)lds + v_rd_base(lane) + wc * 1024;
  u32x4 xs[4];
#define GM_LOAD(g_) do { _Pragma("unroll") for (int i = 0; i < 4; ++i) { const int p = tid + i * NTHR, k = p >> 4, c = (p & 15) * 8; \
      xs[i] = *(const u32x4*)(PROJ + (t0 + k) * INP + C_V + (g_) * 128 + c); } } while (0)
#define GM_STAGE(g_) do { char* tb_ = lds + ((g_) & 1) * 32768; _Pragma("unroll") for (int i = 0; i < 4; ++i) { const int p = tid + i * NTHR, k = p >> 4, c = (p & 15) * 8; \
      const u32x4 x = xs[i]; const float mean = stats[k * 2], rstd = stats[k * 2 + 1]; \
      const f32x4 g0 = *(const f32x4*)(ln_g + (g_) * 128 + c), g1 = *(const f32x4*)(ln_g + (g_) * 128 + c + 4); \
      const f32x4 b0 = *(const f32x4*)(ln_b + (g_) * 128 + c), b1 = *(const f32x4*)(ln_b + (g_) * 128 + c + 4); \
      u32x4 w; \
      w[0] = cvtpk((bflo(x[0]) - mean) * rstd * g0[0] + b0[0], (bfhi(x[0]) - mean) * rstd * g0[1] + b0[1]); \
      w[1] = cvtpk((bflo(x[1]) - mean) * rstd * g0[2] + b0[2], (bfhi(x[1]) - mean) * rstd * g0[3] + b0[3]); \
      w[2] = cvtpk((bflo(x[2]) - mean) * rstd * g1[0] + b1[0], (bfhi(x[2]) - mean) * rstd * g1[1] + b1[1]); \
      w[3] = cvtpk((bflo(x[3]) - mean) * rstd * g1[2] + b1[2], (bfhi(x[3]) - mean) * rstd * g1[3] + b1[3]); \
      *(u32x4*)(tb_ + (k >> 6) * 16384 + v_st(k & 63, c)) = w; } } while (0)
  GM_LOAD(0); GM_STAGE(0);
  bf16x8 a[8];
#pragma unroll
  for (int ks = 0; ks < 8; ++ks) a[ks] = *(const bf16x8*)(WSs + (32 * mi + r32) * 128 + ks * 16 + hi * 8);
  __syncthreads();
  for (int g = 0; g < 8; ++g) {
    if (g + 1 < 8) GM_LOAD(g + 1);
    const int vbg = vb + (g & 1) * 32768;
    bf16_t uv[16][2];
#pragma unroll
    for (int r = 0; r < 16; ++r)
#pragma unroll
      for (int d = 0; d < 2; ++d) uv[r][d] = PROJ[(t0 + 32 * mi + crow(r, hi)) * INP + C_U + g * 128 + wc * 64 + d * 32 + r32];
    f32x16 od[2];
#pragma unroll
    for (int r = 0; r < 16; ++r) { od[0][r] = 0.f; od[1][r] = 0.f; }
    pv_one<0>(od[0], vbg, a[0], a[1], a[2], a[3]); pv_one<0>(od[0], vbg + 16384, a[4], a[5], a[6], a[7]);
    pv_one<1>(od[1], vbg, a[0], a[1], a[2], a[3]); pv_one<1>(od[1], vbg + 16384, a[4], a[5], a[6], a[7]);
    if (g + 1 < 8) {
#pragma unroll
      for (int ks = 0; ks < 8; ++ks) a[ks] = *(const bf16x8*)(WSs + (size_t)(g + 1) * 16384 + (32 * mi + r32) * 128 + ks * 16 + hi * 8);
      GM_STAGE(g + 1);
    }
#pragma unroll
    for (int r = 0; r < 16; ++r) {
      const int row = 32 * mi + crow(r, hi); const float bs = b_s[g * 128 + row];
#pragma unroll
      for (int d = 0; d < 2; ++d) {
        bf16_t* up = PROJ + (t0 + row) * INP + C_U + g * 128 + wc * 64 + d * 32 + r32;
        *up = f2bf(bf2f(uv[r][d]) * (od[d][r] + bs));
      }
    }
    __syncthreads();
  }
#undef GM_LOAD
#undef GM_STAGE
}

DEV void phase_cvt(const float* __restrict__ x, bf16_t* __restrict__ h, float* __restrict__ rs, int T, int gwave, int nwaves, int lane) {
  for (int row = gwave; row < T; row += nwaves) {
    f32x4 v[4]; float ss = 0.f;
#pragma unroll
    for (int i = 0; i < 4; ++i) { v[i] = *(const f32x4*)(x + (size_t)row * 1024 + i * 256 + lane * 4); ss += (v[i][0] * v[i][0] + v[i][1] * v[i][1]) + (v[i][2] * v[i][2] + v[i][3] * v[i][3]); }
#pragma unroll
    for (int off = 32; off > 0; off >>= 1) ss += __shfl_xor(ss, off);
    if (lane == 0) rs[row] = rsqrtf(ss * (1.f / 1024.f) + EPS);
#pragma unroll
    for (int i = 0; i < 4; ++i) { u32x2 w = {cvtpk(v[i][0], v[i][1]), cvtpk(v[i][2], v[i][3])}; *(u32x2*)(h + (size_t)row * 1024 + i * 256 + lane * 4) = w; }
  }
}
DEV void phase_resnorm(const bf16_t* __restrict__ y, const float* xin, const float* __restrict__ gain, float* xout, bf16_t* __restrict__ h, float* __restrict__ rsout, int T, int gwave, int nwaves, int lane) {
  constexpr int NB = 4;
  f32x4 gg[4];
#pragma unroll
  for (int i = 0; i < 4; ++i) gg[i] = *(const f32x4*)(gain + i * 256 + lane * 4);
  for (int row0 = gwave; row0 < T; row0 += NB * nwaves) {
    u32x2 yw[NB][4]; f32x4 xi[NB][4]; float ss[NB], s2[NB];
#pragma unroll
    for (int j = 0; j < NB; ++j)
#pragma unroll
      for (int i = 0; i < 4; ++i) yw[j][i] = *(const u32x2*)(y + (size_t)(row0 + j * nwaves) * 1024 + i * 256 + lane * 4);
#pragma unroll
    for (int j = 0; j < NB; ++j)
#pragma unroll
      for (int i = 0; i < 4; ++i) xi[j][i] = *(const f32x4*)(xin + (size_t)(row0 + j * nwaves) * 1024 + i * 256 + lane * 4);
#pragma unroll
    for (int j = 0; j < NB; ++j) { ss[j] = 0.f;
#pragma unroll
      for (int i = 0; i < 4; ++i) { const float a = bflo(yw[j][i][0]), b2 = bfhi(yw[j][i][0]), c = bflo(yw[j][i][1]), d = bfhi(yw[j][i][1]); ss[j] += (a * a + b2 * b2) + (c * c + d * d); } }
#pragma unroll
    for (int off = 32; off > 0; off >>= 1)
#pragma unroll
      for (int j = 0; j < NB; ++j) ss[j] += __shfl_xor(ss[j], off);
#pragma unroll
    for (int j = 0; j < NB; ++j) {
      const float rstd = rsqrtf(ss[j] * (1.f / 1024.f) + EPS); const size_t ro = (size_t)(row0 + j * nwaves) * 1024; s2[j] = 0.f;
#pragma unroll
      for (int i = 0; i < 4; ++i) {
        const int c = i * 256 + lane * 4;
        f32x4 o; o[0] = xi[j][i][0] + bflo(yw[j][i][0]) * rstd * gg[i][0]; o[1] = xi[j][i][1] + bfhi(yw[j][i][0]) * rstd * gg[i][1];
        o[2] = xi[j][i][2] + bflo(yw[j][i][1]) * rstd * gg[i][2]; o[3] = xi[j][i][3] + bfhi(yw[j][i][1]) * rstd * gg[i][3];
        s2[j] += (o[0] * o[0] + o[1] * o[1]) + (o[2] * o[2] + o[3] * o[3]);
        *(f32x4*)(xout + ro + c) = o;
        if (h) { u32x2 w = {cvtpk(o[0], o[1]), cvtpk(o[2], o[3])}; *(u32x2*)(h + ro + c) = w; }
      }
    }
    if (rsout) {
#pragma unroll
      for (int off = 32; off > 0; off >>= 1)
#pragma unroll
        for (int j = 0; j < NB; ++j) s2[j] += __shfl_xor(s2[j], off);
      if (lane == 0) {
#pragma unroll
        for (int j = 0; j < NB; ++j) rsout[row0 + j * nwaves] = rsqrtf(s2[j] * (1.f / 1024.f) + EPS);
      }
    }
  }
}

enum { MAP_ID = 0, MAP_IN = 1, MAP_UQ = 2, MAP_GU = 3 };
template <int MAP>
DEV void prep_w(bf16_t* __restrict__ dst, int Nd, int K, const float* __restrict__ src, const float* __restrict__ src2, int Ns, const float* __restrict__ gain, int gtid, int gsz) {
  const int kbn = K >> 3; const long total = (long)Nd * kbn;
  for (long idx = gtid; idx < total; idx += gsz) {
    const int n = (int)(idx % Nd), kb = (int)(idx / Nd);
    const float* s = src; int sc = n; bool zero = false;
    if (MAP == MAP_IN) {
      if (n >= C_END) zero = true;
      else if (n >= C_Q && n < C_VV) { const int j = (n - C_Q) & 127; sc = n - j + (j >> 1) + 64 * (j & 1); }
      else if (n >= C_KR && n < C_Q) { const int j = n - C_KR; sc = C_KR + (j >> 1) + 32 * (j & 1); }
    } else if (MAP == MAP_UQ) {
      const int h = n / 192, j = n % 192;
      if (j >= 128) { const int jj = j - 128; sc = h * 192 + 128 + (jj >> 1) + 32 * (jj & 1); }
    } else if (MAP == MAP_GU) {
      const int b = n >> 8, j = n & 255;
      if (j < 128) sc = b * 128 + j; else { s = src2; sc = b * 128 + j - 128; }
    }
    float v[8];
#pragma unroll
    for (int i = 0; i < 8; ++i) { const int k = kb * 8 + i; v[i] = zero ? 0.f : s[(size_t)k * Ns + sc] * (gain ? gain[k] : 1.f); }
    u32x4 w = {cvtpk(v[0], v[1]), cvtpk(v[2], v[3]), cvtpk(v[4], v[5]), cvtpk(v[6], v[7])};
    *(u32x4*)(dst + (size_t)n * K + kb * 8) = w;
  }
}

template <int KIND>
DEV void p2_epi(const f32x16& a, const float* rs, bf16_t* PROJ, unsigned ob, bf16_t* KM, const float2* RT, int pos0, int col) {
#pragma unroll
  for (int r = 0; r < 16; ++r) {
    const int dr = (r & 3) + 8 * (r >> 2);
    float v = a[r] * rs[dr];
    if (KIND == 0) PROJ[ob + dr * INP] = f2bf(gelu_t(v));
    else if (KIND == 1) PROJ[ob + dr * INP] = f2bf(v);
    else if (KIND == 4) PROJ[ob + dr * INP] = f2bf(sigm(v));
    else if (KIND == 3) {
      const float pr = __shfl_xor(v, 1); const int j = (col - C_Q) & 127;
      const float2 cs = RT[(pos0 + dr) * 64 + (j >> 1)];
      PROJ[ob + dr * INP] = f2bf((j & 1) ? (v * cs.x + pr * cs.y) : (v * cs.x - pr * cs.y));
    } else {
      const float pr = __shfl_xor(v, 1); const int j = col - C_KR;
      const float2 cs = RT[(pos0 + dr) * 32 + (j >> 1)];
      const bf16_t o = f2bf((j & 1) ? (v * cs.x + pr * cs.y) : (v * cs.x - pr * cs.y));
#pragma unroll
      for (int h = 0; h < 8; ++h) KM[ob + dr * 1536 + h * 192 + 128 + j] = o;
    }
  }
}
namespace pg8 {
#define PG8_LAS __attribute__((address_space(3)))
typedef unsigned short bf16_t;
typedef short bf16x8 __attribute__((ext_vector_type(8)));
typedef float f32x4 __attribute__((ext_vector_type(4)));
typedef unsigned u32x4 __attribute__((ext_vector_type(4)));
constexpr int BM = 256, BK = 64, HALF = 128, HTB = HALF * BK * 2  , STAGE_BYTES = 8 * HTB, NXCD = 8, WGM = 8;

__host__ __device__ __forceinline__ int lds_byte(int r, int c) { const int st = (r >> 4) * 2 + (c >> 5), rr = r & 15, cc = c & 31, ob = rr * 64 + cc * 2; return st * 1024 + (ob ^ (((ob >> 9) & 1) << 5)); }
__host__ __device__ __forceinline__ void stage_rc(int b, int& R, int& C) { const int st = b / 1024, sb = b % 1024, swz = sb ^ (((sb >> 9) & 1) << 5); R = (st >> 1) * 16 + swz / 64; C = (st & 1) * 32 + (swz % 64) / 2; }
__host__ __device__ __forceinline__ int perm32(int rho) { const int n = rho >> 4, i = rho & 15; return 8 * (i >> 2) + 4 * n + (i & 3); }

struct Unit { int pm, pn; };
struct Gemm { const bf16_t* A; const bf16_t* Bt; int M, N, K; };

struct StaticOrder {
    int nM, nN, nwg, G, c;
    __host__ __device__ void init(int M, int N, int G_, int c_) { nM = M / BM; nN = N / BM; nwg = nM * nN; G = G_; c = c_; }
    __host__ __device__ bool next(int i, Unit& u) const {
        const long L = (long)i * G + c; if (L >= nwg) return false;
        int wgid = (int)L; { const int q = nwg / NXCD, r = nwg % NXCD, xcd = wgid % NXCD, off = wgid / NXCD; wgid = (xcd < r ? xcd * (q + 1) : r * (q + 1) + (xcd - r) * q) + off; }
        const int nig = WGM * nN, gid = wgid / nig, fm = gid * WGM, gsz = (nM - fm) < WGM ? (nM - fm) : WGM;
        u.pm = fm + ((wgid % nig) % gsz); u.pn = (wgid % nig) / gsz; return true;
    }
    __device__ __forceinline__ void a_ready(const Unit&) const {}
    __device__ __forceinline__ void done(const Unit&) const {}
};


template <class Epi, class Sched, bool ALIGN_EPI = false, bool SP2 = false>
__device__ __forceinline__ void gemm_phase(PG8_LAS unsigned char* lds, const Gemm g, const Sched& S, const Epi& E, const int lda_in = 0) {
    const int tid = ltid(), wid = __builtin_amdgcn_readfirstlane(tid >> 6), lane = tid & 63, wr = wid >> 2, wc = wid & 3, fr = lane & 15, fq = lane >> 4;
    const int K = g.K, nt = K / BK, lda = lda_in ? lda_in : K;
    unsigned voffA[2], voffB[2];
#pragma unroll
    for (int i = 0; i < 2; ++i) { int R, C; stage_rc(tid * 16 + i * 8192, R, C); const int Rb = Epi::PERM ? ((R & ~31) + perm32(R & 31)) : R;
        voffA[i] = (unsigned)(R * lda + C) * 2u; voffB[i] = (unsigned)(Rb * K + C) * 2u; }
    const size_t kstep = (size_t)(BK * 2);
    const size_t hstep = (size_t)HALF * K * 2;
    const size_t tstep = 2 * hstep;
    const size_t hstepA = (size_t)HALF * lda * 2, tstepA = 2 * hstepA;
    const unsigned ldsw = (unsigned)wid * 1024u;
    const int aoff = lds_byte(wr * 64 + fr, fq * 8), boff = lds_byte(wc * 32 + fr, fq * 8);
#define PG8_SA(b, h) (((b) * 2 + (h)) * HTB)
#define PG8_SB(b, h) ((4 + (b) * 2 + (h)) * HTB)
#define PG8_STAGE(bufoff, gbase, voff) do { _Pragma("unroll") for (int _i = 0; _i < 2; ++_i) \
        __builtin_amdgcn_global_load_lds((const unsigned*)((const char*)(gbase) + (voff)[_i]), (PG8_LAS unsigned*)(lds + (bufoff) + ldsw + _i * 8192), 16, 0, 0); } while (0)
#define PG8_LDA(dst, b, h) do { _Pragma("unroll") for (int m = 0; m < 4; ++m) _Pragma("unroll") for (int k = 0; k < 2; ++k) dst[m][k] = *(const PG8_LAS bf16x8*)(lds + PG8_SA(b, h) + aoff + m * 2048 + k * 1024); } while (0)
#define PG8_LDB(dst, b, h) do { _Pragma("unroll") for (int n = 0; n < 2; ++n) _Pragma("unroll") for (int k = 0; k < 2; ++k) dst[n][k] = *(const PG8_LAS bf16x8*)(lds + PG8_SB(b, h) + boff + n * 2048 + k * 1024); } while (0)
#define PG8_MMA(ai, bj, At, Bt) do { __builtin_amdgcn_s_setprio(1); _Pragma("unroll") for (int m = 0; m < 4; ++m) _Pragma("unroll") for (int n = 0; n < 2; ++n) _Pragma("unroll") for (int k = 0; k < 2; ++k) \
        acc[ai][bj][m][n] = __builtin_amdgcn_mfma_f32_16x16x32_bf16(Bt[n][k], At[m][k], acc[ai][bj][m][n], 0, 0, 0); __builtin_amdgcn_s_setprio(0); } while (0)
#define PG8_WAIT_V(n) asm volatile("s_waitcnt vmcnt(" #n ")" ::: "memory")
#define PG8_WAIT_L(n) asm volatile("s_waitcnt lgkmcnt(" #n ")" ::: "memory")
#define PG8_BAR __builtin_amdgcn_s_barrier()
#define PG8_SCHED __builtin_amdgcn_sched_barrier(0)
    Unit cur, nxt; int ui = 0;
    if (!S.next(0, cur)) return;
    f32x4 acc[2][2][4][2];
#pragma unroll
    for (int a = 0; a < 2; ++a)
#pragma unroll
        for (int b = 0; b < 2; ++b)
#pragma unroll
            for (int m = 0; m < 4; ++m)
#pragma unroll
                for (int n = 0; n < 2; ++n) acc[a][b][m][n] = (f32x4){0.f, 0.f, 0.f, 0.f};
    bf16x8 At[4][2], B0[2][2], B1[2][2];
    const char* cA = (const char*)g.A + (size_t)cur.pm * tstepA; const char* cB = (const char*)g.Bt + (size_t)cur.pn * tstep;
    S.a_ready(cur);
    if constexpr (SP2) {
        PG8_STAGE(PG8_SB(0, 0), cB, voffB); PG8_STAGE(PG8_SB(0, 1), cB + hstep, voffB); PG8_STAGE(PG8_SA(0, 0), cA, voffA); PG8_STAGE(PG8_SA(0, 1), cA + hstepA, voffA);
        if (wr == 1) PG8_BAR;
        PG8_WAIT_V(2); PG8_BAR;
        PG8_STAGE(PG8_SB(1, 0), cB + kstep, voffB); PG8_STAGE(PG8_SA(1, 0), cA + kstep, voffA); PG8_STAGE(PG8_SB(1, 1), cB + hstep + kstep, voffB);
        PG8_WAIT_V(6); PG8_BAR;
    } else {
        PG8_STAGE(PG8_SB(0, 0), cB, voffB); PG8_STAGE(PG8_SA(0, 0), cA, voffA); PG8_STAGE(PG8_SB(0, 1), cB + hstep, voffB); PG8_STAGE(PG8_SA(0, 1), cA + hstepA, voffA);
        if (wr == 1) PG8_BAR;
        PG8_WAIT_V(4); PG8_BAR;
        PG8_STAGE(PG8_SB(1, 0), cB + kstep, voffB); PG8_STAGE(PG8_SA(1, 0), cA + kstep, voffA); PG8_STAGE(PG8_SB(1, 1), cB + hstep + kstep, voffB);
        PG8_WAIT_V(6); PG8_BAR;
    }
    for (;;) {
        const bool has_next = S.next(ui + 1, nxt);
        const char* nA = has_next ? (const char*)g.A + (size_t)nxt.pm * tstepA : cA; const char* nB = has_next ? (const char*)g.Bt + (size_t)nxt.pn * tstep : cB;
        for (int t = 0; t < nt; t += 2) {
            const bool last = (t == nt - 2);
            const char* a1 = cA + (size_t)(t + 1) * kstep;
            const char* a2 = last ? nA : cA + (size_t)(t + 2) * kstep; const char* b2 = last ? nB : cB + (size_t)(t + 2) * kstep;
            const char* a3 = a2 + kstep; const char* b3 = b2 + kstep;
            if (last && has_next) S.a_ready(nxt);
            if constexpr (SP2) {
            PG8_LDB(B0, 0, 0); PG8_LDB(B1, 0, 1); PG8_SCHED; PG8_LDA(At, 0, 0); PG8_STAGE(PG8_SA(1, 1), a1 + hstepA, voffA);
            PG8_WAIT_V(8); PG8_WAIT_L(0); PG8_BAR; PG8_MMA(0, 0, At, B0); PG8_MMA(0, 1, At, B1); PG8_BAR; PG8_SCHED;
            PG8_LDA(At, 0, 1); PG8_STAGE(PG8_SB(0, 0), b2, voffB); PG8_STAGE(PG8_SB(0, 1), b2 + hstep, voffB); PG8_STAGE(PG8_SA(0, 0), a2, voffA);
            PG8_WAIT_V(8); PG8_WAIT_L(0); PG8_BAR; PG8_MMA(1, 0, At, B0); PG8_MMA(1, 1, At, B1); PG8_BAR; PG8_SCHED;
            PG8_LDB(B0, 1, 0); PG8_LDB(B1, 1, 1); PG8_SCHED; PG8_LDA(At, 1, 0); PG8_STAGE(PG8_SA(0, 1), a2 + hstepA, voffA);
            PG8_WAIT_V(8); PG8_WAIT_L(0); PG8_BAR; PG8_MMA(0, 0, At, B0); PG8_MMA(0, 1, At, B1); PG8_BAR; PG8_SCHED;
            PG8_LDA(At, 1, 1); PG8_STAGE(PG8_SB(1, 0), b3, voffB); PG8_STAGE(PG8_SB(1, 1), b3 + hstep, voffB); PG8_STAGE(PG8_SA(1, 0), a3, voffA);
            PG8_WAIT_V(8); PG8_WAIT_L(0); PG8_BAR; PG8_MMA(1, 0, At, B0); PG8_MMA(1, 1, At, B1); PG8_BAR; PG8_SCHED;
            } else {
            PG8_LDB(B0, 0, 0); PG8_SCHED; PG8_LDA(At, 0, 0); PG8_STAGE(PG8_SA(1, 1), a1 + hstepA, voffA);
            PG8_WAIT_L(8); PG8_BAR; PG8_WAIT_L(0); PG8_MMA(0, 0, At, B0); PG8_BAR; PG8_SCHED;
            PG8_LDB(B1, 0, 1); PG8_STAGE(PG8_SB(0, 0), b2, voffB);
            PG8_BAR; PG8_WAIT_L(0); PG8_MMA(0, 1, At, B1); PG8_BAR;
            PG8_LDA(At, 0, 1); PG8_STAGE(PG8_SA(0, 0), a2, voffA);
            PG8_BAR; PG8_WAIT_L(0); PG8_MMA(1, 0, At, B0); PG8_BAR; PG8_SCHED;
            PG8_STAGE(PG8_SB(0, 1), b2 + hstep, voffB);
            PG8_WAIT_V(6); PG8_BAR; PG8_MMA(1, 1, At, B1); PG8_BAR;
            PG8_LDB(B0, 1, 0); PG8_SCHED; PG8_LDA(At, 1, 0); PG8_STAGE(PG8_SA(0, 1), a2 + hstepA, voffA);
            PG8_WAIT_L(8); PG8_BAR; PG8_WAIT_L(0); PG8_MMA(0, 0, At, B0); PG8_BAR; PG8_SCHED;
            PG8_LDB(B1, 1, 1); PG8_STAGE(PG8_SB(1, 0), b3, voffB);
            PG8_BAR; PG8_WAIT_L(0); PG8_MMA(0, 1, At, B1); PG8_BAR;
            PG8_LDA(At, 1, 1); PG8_STAGE(PG8_SA(1, 0), a3, voffA);
            PG8_BAR; PG8_WAIT_L(0); PG8_MMA(1, 0, At, B0); PG8_BAR; PG8_SCHED;
            PG8_STAGE(PG8_SB(1, 1), b3 + hstep, voffB);
            PG8_WAIT_V(6); PG8_BAR; PG8_MMA(1, 1, At, B1); PG8_BAR;
            }
        }
        if constexpr (ALIGN_EPI) { if (wr == 0) PG8_BAR; }
        if constexpr (!Epi::AFTER_DRAIN) { E(acc, cur, wr, wc, fr, fq); S.done(cur); }
        if (!has_next) break;
#pragma unroll
        for (int a = 0; a < 2; ++a)
#pragma unroll
            for (int b = 0; b < 2; ++b)
#pragma unroll
                for (int m = 0; m < 4; ++m)
#pragma unroll
                    for (int n = 0; n < 2; ++n) acc[a][b][m][n] = (f32x4){0.f, 0.f, 0.f, 0.f};
        cur = nxt; cA = nA; cB = nB; ++ui;
        if constexpr (ALIGN_EPI) { if (wr == 1) PG8_BAR; }
    }
    PG8_WAIT_V(0);
    if constexpr (!ALIGN_EPI) { if (wr == 0) PG8_BAR; }
    PG8_BAR;
    if constexpr (Epi::AFTER_DRAIN) { E.fused(acc, cur, wr, wc, fr, fq, lds, wid, lane); S.done(cur); }
#undef PG8_SA
#undef PG8_SB
#undef PG8_STAGE
#undef PG8_LDA
#undef PG8_LDB
#undef PG8_MMA
#undef PG8_WAIT_V
#undef PG8_WAIT_L
#undef PG8_BAR
#undef PG8_SCHED
}
}


struct EpiF32 {
  static constexpr bool PERM = false, AFTER_DRAIN = false;
  bf16_t* OUT;
  __device__ __forceinline__ void operator()(const pg8::f32x4 (&acc)[2][2][4][2], const pg8::Unit& u, int wr, int wc, int fr, int fq) const {
#pragma unroll
    for (int ai = 0; ai < 2; ++ai)
#pragma unroll
      for (int m = 0; m < 4; ++m) {
        bf16_t* rp = OUT + (size_t)(u.pm * 256 + ai * 128 + wr * 64 + m * 16 + fr) * 1024 + u.pn * 256 + wc * 32 + 4 * fq;
#pragma unroll
        for (int bj = 0; bj < 2; ++bj)
#pragma unroll
          for (int n = 0; n < 2; ++n) { const pg8::f32x4 v = acc[ai][bj][m][n]; u32x2 w; w[0] = cvtpk(v[0], v[1]); w[1] = cvtpk(v[2], v[3]); *(u32x2*)(rp + bj * 128 + n * 16) = w; }
      }
  }
};
struct EpiSwiGLU {
  static constexpr bool PERM = false, AFTER_DRAIN = false;
  bf16_t* TT; const float* RS;
  __device__ __forceinline__ void operator()(const pg8::f32x4 (&acc)[2][2][4][2], const pg8::Unit& u, int wr, int wc, int fr, int fq) const {
#pragma unroll
    for (int ai = 0; ai < 2; ++ai)
#pragma unroll
      for (int m = 0; m < 4; ++m) {
        const int row = u.pm * 256 + ai * 128 + wr * 64 + m * 16 + fr; const float rs = RS[row];
        bf16_t* rp = TT + (size_t)row * DFF + u.pn * 128 + wc * 32 + 4 * fq;
#pragma unroll
        for (int n = 0; n < 2; ++n) {
          const pg8::f32x4 g = acc[ai][0][m][n] * rs, uu = acc[ai][1][m][n] * rs;
          u32x2 w; w[0] = cvtpk(g[0] * sigm(g[0]) * uu[0], g[1] * sigm(g[1]) * uu[1]); w[1] = cvtpk(g[2] * sigm(g[2]) * uu[2], g[3] * sigm(g[3]) * uu[3]);
          *(u32x2*)(rp + n * 16) = w;
        }
      }
  }
};
struct EpiIn {
  static constexpr bool PERM = true, AFTER_DRAIN = false;
  bf16_t* PROJ; bf16_t* KM; const float2* R64; const float2* R128; const float* RS; int seqmask;
  __device__ __forceinline__ void operator()(const pg8::f32x4 (&acc)[2][2][4][2], const pg8::Unit& u, int wr, int wc, int fr, int fq) const {
#pragma unroll
    for (int bj = 0; bj < 2; ++bj) {
      const int cb = u.pn * 256 + bj * 128 + wc * 32;
      if (cb >= C_END) continue;
      const int kind = cb < C_CQL ? 0 : ((cb < C_KR || (cb >= C_VV && cb < C_G)) ? 1 : (cb < C_Q ? 2 : (cb < C_VV ? 3 : 4)));
      const int c0 = cb + 8 * fq;
#pragma unroll
      for (int ai = 0; ai < 2; ++ai)
#pragma unroll
        for (int m = 0; m < 4; ++m) {
          const int row = u.pm * 256 + ai * 128 + wr * 64 + m * 16 + fr; const float rs = RS[row]; const int pos = row & seqmask;
          u32x4 w;
#pragma unroll
          for (int n = 0; n < 2; ++n) {
            pg8::f32x4 v = acc[ai][bj][m][n] * rs;
            if (kind == 0) { v[0] = gelu_t(v[0]); v[1] = gelu_t(v[1]); v[2] = gelu_t(v[2]); v[3] = gelu_t(v[3]); }
            else if (kind == 4) { v[0] = sigm(v[0]); v[1] = sigm(v[1]); v[2] = sigm(v[2]); v[3] = sigm(v[3]); }
            else if (kind == 3 || kind == 2) {
              const pg8::f32x4 cs = kind == 3 ? *(const pg8::f32x4*)(R128 + pos * 64 + ((((c0 + 4 * n) - C_Q) & 127) >> 1))
                                              : *(const pg8::f32x4*)(R64 + pos * 32 + (((c0 + 4 * n) - C_KR) >> 1));
              const float a0 = v[0] * cs[0] - v[1] * cs[1], a1 = v[1] * cs[0] + v[0] * cs[1], a2 = v[2] * cs[2] - v[3] * cs[3], a3 = v[3] * cs[2] + v[2] * cs[3];
              v[0] = a0; v[1] = a1; v[2] = a2; v[3] = a3;
            }
            w[2 * n] = cvtpk(v[0], v[1]); w[2 * n + 1] = cvtpk(v[2], v[3]);
          }
          if (kind == 2) {
#pragma unroll
            for (int h = 0; h < 8; ++h) *(u32x4*)(KM + (size_t)row * 1536 + h * 192 + 128 + (c0 - C_KR)) = w;
          } else *(u32x4*)(PROJ + (size_t)row * INP + c0) = w;
        }
    }
  }
};

template <int STEP> struct EpiGate {
  static constexpr bool PERM = false, AFTER_DRAIN = false;
  const bf16_t* G; float* MACC; bf16_t* OUT;
  __device__ __forceinline__ void operator()(const pg8::f32x4 (&acc)[2][2][4][2], const pg8::Unit& u, int wr, int wc, int fr, int fq) const {
#pragma unroll
    for (int ai = 0; ai < 2; ++ai)
#pragma unroll
      for (int m = 0; m < 4; ++m) {
        const int row = u.pm * 256 + ai * 128 + wr * 64 + m * 16 + fr; const int c0 = u.pn * 256 + wc * 32 + 4 * fq;
#pragma unroll
        for (int bj = 0; bj < 2; ++bj)
#pragma unroll
          for (int n = 0; n < 2; ++n) {
            const int c = c0 + bj * 128 + n * 16;
            const u32x2 gw = *(const u32x2*)(G + (size_t)row * INP + c);
            pg8::f32x4 v = acc[ai][bj][m][n];
            v[0] *= bflo(gw[0]); v[1] *= bfhi(gw[0]); v[2] *= bflo(gw[1]); v[3] *= bfhi(gw[1]);
            float* mp = MACC + (size_t)row * 1024 + c;
            if (STEP > 0) v += *(const pg8::f32x4*)mp;
            if (STEP < 2) *(pg8::f32x4*)mp = v;
            else { u32x2 w; w[0] = cvtpk(v[0], v[1]); w[1] = cvtpk(v[2], v[3]); *(u32x2*)(OUT + (size_t)row * 1024 + c) = w; }
          }
      }
  }
};

#define LAS __attribute__((address_space(3)))
#define XB_TMO      128
#define XB_XCNT(j)  (256  + 64 * (j))
#define XB_XSUB(j)  (1280 + 64 * (j))
#define XB_XGEN(j)  (2304 + 64 * (j))
#define XB_TOP      3328
#define XB_TOPGEN   3392
#define XCD_BAR_WORDS 3456
#define XB_SPIN_CAP (1u << 22)

__device__ __forceinline__ unsigned xb_ld(unsigned* p)              { return __hip_atomic_load(p, __ATOMIC_RELAXED, __HIP_MEMORY_SCOPE_AGENT); }
__device__ __forceinline__ unsigned xb_add(unsigned* p, unsigned v) { return __hip_atomic_fetch_add(p, v, __ATOMIC_RELAXED, __HIP_MEMORY_SCOPE_AGENT); }
__device__ __forceinline__ unsigned xb_xcc_id() { return (unsigned)__builtin_amdgcn_s_getreg((3 << 11) | 20) & 0xFu; }
#define XB_SPIN(cond, bar) do { unsigned _sp = 0; while (cond) { __builtin_amdgcn_s_sleep(1); \
    if ((++_sp & 255u) == 0u) { if (xb_ld(&(bar)[XB_TMO])) break; if (_sp > XB_SPIN_CAP) { atomicAdd(&(bar)[XB_TMO], 1u); break; } } } } while (0)

struct XcdBarrier {
    unsigned* bar; unsigned x;
    volatile LAS unsigned* st;
};

__device__ __forceinline__ XcdBarrier xcd_barrier_post(unsigned* bar, volatile LAS unsigned* st) {
    XcdBarrier b; b.bar = bar; b.x = xb_xcc_id(); b.st = st;
    if (threadIdx.x == 0) (void)xb_add(&bar[XB_XCNT(b.x)], 1u);
    return b;
}
__device__ __forceinline__ void xcd_barrier_complete(unsigned* bar, unsigned x, unsigned& nloc, unsigned& nx) {
    const unsigned G = gridDim.x * gridDim.y * gridDim.z;
    unsigned sum, cnt, mine, sp = 0u;
    for (;;) {
        sum = 0u; cnt = 0u; mine = 0u;
#pragma unroll
        for (unsigned j = 0; j < 16; ++j) { const unsigned c = xb_ld(&bar[XB_XCNT(j)]); sum += c; cnt += (c > 0u) ? 1u : 0u; mine = (j == x) ? c : mine; }
        if (sum == G) break;
        __builtin_amdgcn_s_sleep(1);
        if ((++sp & 255u) == 0u) { if (xb_ld(&bar[XB_TMO])) break; if (sp > XB_SPIN_CAP) { atomicAdd(&bar[XB_TMO], 1u); break; } }
    }
    nloc = mine > 0u ? mine : 1u; nx = cnt > 0u ? cnt : 1u;
}

__device__ __forceinline__ void xcd_barrier(const XcdBarrier& b) {
    asm volatile("s_waitcnt vmcnt(0)" ::: "memory");
    __syncthreads();
    if (threadIdx.x == 0) {
        unsigned* bar = b.bar;
        __builtin_amdgcn_s_waitcnt(0);
        unsigned nloc = b.st[0], nx = b.st[1];
        if (nloc == 0u) { xcd_barrier_complete(bar, b.x, nloc, nx); b.st[0] = nloc; b.st[1] = nx; }
        const unsigned old = xb_add(&bar[XB_XSUB(b.x)], 1u);
        const unsigned gen = old / nloc;
        if (old + 1u == (gen + 1u) * nloc) {
            __builtin_amdgcn_fence(__ATOMIC_RELEASE, "agent");
            asm volatile("s_waitcnt vmcnt(0)" ::: "memory");
            const unsigned og = xb_add(&bar[XB_TOP], 1u);
            const unsigned tg = og / nx;
            if (og + 1u == (tg + 1u) * nx) xb_add(&bar[XB_TOPGEN], 1u);
            else XB_SPIN(xb_ld(&bar[XB_TOPGEN]) == tg, bar);
            __builtin_amdgcn_fence(__ATOMIC_ACQUIRE, "agent");
            xb_add(&bar[XB_XGEN(b.x)], 1u);
            asm volatile("s_waitcnt vmcnt(0)" ::: "memory");
        } else {
            XB_SPIN(xb_ld(&bar[XB_XGEN(b.x)]) == gen, bar);
            __builtin_amdgcn_fence(__ATOMIC_ACQUIRE, "agent");
            asm volatile("s_waitcnt vmcnt(0)" ::: "memory");
        }
    }
    __syncthreads();
}


DEV void tile_map(int u, int nM, int nN, int& pm, int& pn) {
  const int x = u & 7, t = u >> 3, ML = nM >> 3, per = 4 * nN;
  const int band = t / per, idx = t - band * per;
  pm = x * ML + band * 4 + (idx & 3); pn = idx >> 2;
}

#define TIDX() const int tid = ltid(), lane = tid & 63, wid = tid >> 6, r32 = lane & 31, hi = lane >> 5, wm = wid & 3, wn = wid >> 2; (void)lane; (void)wid; (void)r32; (void)hi; (void)wm; (void)wn
#define GTID() const int gtid = bid * NTHR + ltid(), gsz = nblk * NTHR
DEV void run_phase(const Params& p, const int grp, const int l, const int ph, char* lds) {
  const int nblk = gridDim.x, bid = blockIdx.x;
  char* ws = p.ws;
  float2* R128 = (float2*)(ws + O_R128); float2* R64 = (float2*)(ws + O_R64); float* RS1 = (float*)(ws + O_RS1); float* RS2 = (float*)(ws + O_RS2);
  bf16_t* HN = (bf16_t*)(ws + O_HN); bf16_t* PROJ = (bf16_t*)(ws + O_PROJ); bf16_t* QM = (bf16_t*)(ws + O_QM); bf16_t* KM = (bf16_t*)(ws + O_KM);
  bf16_t* VM = (bf16_t*)(ws + O_VM); bf16_t* YB = (bf16_t*)(ws + O_YB);
  bf16_t* MERGED = (bf16_t*)(ws + O_MERGED); bf16_t* MIX = (bf16_t*)(ws + O_MIX); bf16_t* H2 = (bf16_t*)(ws + O_H2); bf16_t* TT = (bf16_t*)(ws + O_TT); bf16_t* FF = (bf16_t*)(ws + O_FF);

  const int T = grp < 2 ? 32768 : 16384, seqlen = grp < 2 ? 8192 : 4096, nseq = 4;
  const float* xin0 = grp < 2 ? p.in[0] + (size_t)grp * 32768 * 1024 : p.in[1];
  float* xout = p.out + (size_t)(grp < 2 ? grp * 32768 : 65536) * 1024;
  const char* wl = ws + (size_t)l * WL;
  const float* xres = l == 0 ? xin0 : xout;
  if (ph == 0) {
  { GTID();
  for (int l = 0; l < 2; ++l) {
    char* wl = ws + (size_t)l * WL;
    prep_w<MAP_IN>((bf16_t*)(wl + O_WIN), INP, 1024, p.in[3] + (size_t)l * 1024 * 7360, nullptr, 7360, p.in[2] + l * 1024, gtid, gsz);
    prep_w<MAP_UQ>((bf16_t*)(wl + O_WUQ), 1536, 384, p.in[9] + (size_t)l * 384 * 1536, nullptr, 1536, p.in[8] + l * 384, gtid, gsz);
    prep_w<MAP_ID>((bf16_t*)(wl + O_WUKV), 2048, 256, p.in[11] + (size_t)l * 256 * 2048, nullptr, 2048, p.in[10] + l * 256, gtid, gsz);
    prep_w<MAP_ID>((bf16_t*)(wl + O_WPA), 1024, 1024, p.in[13] + (size_t)l * 1024 * 1024, nullptr, 1024, nullptr, gtid, gsz);
    prep_w<MAP_ID>((bf16_t*)(wl + O_WPB), 1024, 1024, p.in[14] + (size_t)l * 1024 * 1024, nullptr, 1024, nullptr, gtid, gsz);
    prep_w<MAP_ID>((bf16_t*)(wl + O_WPC), 1024, 1024, p.in[15] + (size_t)l * 1024 * 1024, nullptr, 1024, nullptr, gtid, gsz);
    prep_w<MAP_ID>((bf16_t*)(wl + O_WO), 1024, 1024, p.in[16] + (size_t)l * 1024 * 1024, nullptr, 1024, nullptr, gtid, gsz);
    prep_w<MAP_GU>((bf16_t*)(wl + O_WGU), 5632, 1024, p.in[19] + (size_t)l * 1024 * DFF, p.in[20] + (size_t)l * 1024 * DFF, DFF, p.in[18] + l * 1024, gtid, gsz);
    prep_w<MAP_ID>((bf16_t*)(wl + O_WD), 1024, DFF, p.in[21] + (size_t)l * DFF * 1024, nullptr, 1024, nullptr, gtid, gsz);
    { bf16_t* d = (bf16_t*)(wl + O_WS); const float* s = p.in[6] + (size_t)l * 8 * 128 * 128; for (int i = gtid; i < 8 * 128 * 128; i += gsz) d[i] = f2bf(s[i]); }
  }
  for (int i = gtid; i < 8192 * 64; i += gsz) { const int pos = i >> 6, f = i & 63; double rev = (double)pos * RPP128[f]; rev -= floor(rev); const float fr = (float)rev;
    R128[i] = make_float2(__builtin_amdgcn_cosf(fr), __builtin_amdgcn_sinf(fr)); }
  for (int i = gtid; i < 8192 * 32; i += gsz) { const int pos = i >> 5, f = i & 31; double rev = (double)pos * RPP64[f]; rev -= floor(rev); const float fr = (float)rev;
    R64[i] = make_float2(__builtin_amdgcn_cosf(fr), __builtin_amdgcn_sinf(fr)); }
  }
  }
  if (ph == 0) { TIDX(); phase_cvt(p.in[0], HN, RS1, 32768, bid * 8 + wid, nblk * 8, lane); }
      if (ph == 2) {
        pg8::Gemm g{HN, (const bf16_t*)(wl + O_WIN), T, INP, 1024};
        pg8::StaticOrder so; so.init(T, INP, nblk, bid);
        EpiIn e{PROJ, KM, R64, R128, RS1, seqlen - 1};
        pg8::gemm_phase<EpiIn, pg8::StaticOrder, true, true>((PG8_LAS unsigned char*)lds, g, so, e);
      }
      if (ph == 3) {
        const int nG = T / 128, nQ = (T / 256) * 6, nKV = (T / 256) * 8, nU = nG + nQ + nKV;
        for (int u = bid; u < nU; u += nblk) {
          if (u < nG) {
#ifndef NO_GMLP
            gmlp_unit(u, PROJ, (const bf16_t*)(wl + O_WS), p.in[4] + l * 1024, p.in[5] + l * 1024, p.in[7] + l * 1024, lds);
#endif
          } else if (u < nG + nQ) {
            const int v_ = u - nG, nM = T / 256; const int m0 = (v_ % nM) * 256, n0 = (v_ / nM) * 256;
            f32x16 acc[2][4]; float ss[2];
            gemm_mainloop<2, true>(acc, ss, PROJ + (size_t)m0 * INP + C_CQL, INP, (const bf16_t*)(wl + O_WUQ) + (size_t)n0 * 384, 384, 384, lds);
            rowss_finish<2>(ss, 384, lds);
            TIDX();
            const float* rs_l = (const float*)(lds + GemmCfg<2>::RS_OFF);
#pragma unroll
            for (int mi = 0; mi < 2; ++mi) {
              const int rbl = wm * 64 + mi * 32;
#pragma unroll
              for (int nf = 0; nf < 4; ++nf) {
                const int cb = n0 + wn * 128 + nf * 32, col = cb + r32; const int jb = cb % 192;
#pragma unroll
                for (int r = 0; r < 16; ++r) {
                  const int rl = rbl + crow(r, hi); const unsigned row = (unsigned)(m0 + rl);
                  float v = acc[mi][nf][r] * rs_l[rl];
                  if (jb >= 128) {
                    const float pr = __shfl_xor(v, 1); const int j = (jb - 128) + r32; const int pos = (int)row & (seqlen - 1);
                    const float2 cs = R64[pos * 32 + (j >> 1)];
                    v = (j & 1) ? (v * cs.x + pr * cs.y) : (v * cs.x - pr * cs.y);
                  }
                  QM[row * 1536 + col] = f2bf(v);
                }
              }
            }
          } else {
            const int v_ = u - nG - nQ, nM = T / 256; const int m0 = (v_ % nM) * 256, n0 = (v_ / nM) * 256;
            f32x16 acc[2][4]; float ss[2];
            gemm_mainloop<2, true>(acc, ss, PROJ + (size_t)m0 * INP + C_CKV, INP, (const bf16_t*)(wl + O_WUKV) + (size_t)n0 * 256, 256, 256, lds);
            rowss_finish<2>(ss, 256, lds);
            TIDX();
            const float* rs_l = (const float*)(lds + GemmCfg<2>::RS_OFF);
            const int h = n0 >> 8;
#pragma unroll
            for (int mi = 0; mi < 2; ++mi) {
              const int rbl = wm * 64 + mi * 32;
#pragma unroll
              for (int nf = 0; nf < 4; ++nf) {
                const int j = nf * 32 + r32;
#pragma unroll
                for (int r = 0; r < 16; ++r) {
                  const int rl = rbl + crow(r, hi); const unsigned row = (unsigned)(m0 + rl);
                  const bf16_t ob = f2bf(acc[mi][nf][r] * rs_l[rl]);
                  if (wn == 0) KM[row * 1536 + h * 192 + j] = ob; else VM[row * 1024 + h * 128 + j] = ob;
                }
              }
            }
          }
        }
      }
      if (ph == 4) {
        const int nqb = seqlen / 256, nU = nseq * 8 * nqb;
        for (int u = bid; u < nU; u += nblk) {
          const int b = u & 255, i = u >> 8; const int y = b >> 3; const int qb = y % nqb, sub = y / nqb;
          const int sh = (b & 7) + 8 * (i * (32 / nqb) + sub); const int s = sh >> 3, h = sh & 7;
          const size_t tq = (size_t)s * seqlen + (size_t)qb * 256, tk = (size_t)s * seqlen;
#ifndef NO_MLA
          attn_unit<192, false, false>(QM + tq * 1536 + h * 192, 1536, KM + tk * 1536 + h * 192, 1536, VM + tk * 1024 + h * 128, 1024,
                                YB + tq * 1024 + h * 128, 1024, 0, seqlen / 64, qb * 256, 0.f, 0.07216878364870322f, lds);
#else
          { const int t_ = ltid(); for (int e = t_; e < 256 * 128; e += NTHR) YB[(tq + (e >> 7)) * 1024 + h * 128 + (e & 127)] = 0; (void)tk; }
#endif
        }
        const float* sinkp = p.in[12] + l * 8;
        for (int u = bid; u < nU; u += nblk) {
          const int b = u & 255, i = u >> 8; const int y = b >> 3; const int qb = y % nqb, sub = y / nqb;
          const int sh = (b & 7) + 8 * (i * (32 / nqb) + sub); const int s = sh >> 3, h = sh & 7, kvh = h >> 2;
          const size_t tq = (size_t)s * seqlen + (size_t)qb * 256, tk = (size_t)s * seqlen;
          const int q0 = qb * 256; const int kb0 = q0 - 128 < 0 ? 0 : q0 - 128; const int ke = q0 + 384 > seqlen ? seqlen : q0 + 384;
#ifndef NO_GQA
          attn_unit<128, true, true>(PROJ + tq * INP + C_Q + h * 128, INP, PROJ + tk * INP + C_K + kvh * 128, INP, PROJ + tk * INP + C_VV + kvh * 128, INP,
                               PROJ + tq * INP + C_Q + h * 128, INP, kb0, (ke - kb0) / 64, q0, sinkp[h], 0.08838834764831845f, lds);
#else
          { const int t_ = ltid(); for (int e = t_; e < 256 * 128; e += NTHR) PROJ[(tq + (e >> 7)) * INP + C_Q + h * 128 + (e & 127)] = 0; (void)tk; (void)kvh; (void)kb0; (void)ke; (void)sinkp; }
#endif
        }
      }
      if (ph == 5) {
        float* MACC = (float*)(ws + O_QM);
        pg8::StaticOrder so; so.init(T, 1024, nblk, bid);
        { pg8::Gemm g{PROJ + C_U, (const bf16_t*)(wl + O_WPA), T, 1024, 1024}; EpiGate<0> e{PROJ + C_G, MACC, MERGED};
          pg8::gemm_phase<EpiGate<0>, pg8::StaticOrder, true, true>((PG8_LAS unsigned char*)lds, g, so, e, INP); }
        { pg8::Gemm g{YB, (const bf16_t*)(wl + O_WPB), T, 1024, 1024}; EpiGate<1> e{PROJ + C_G + 1024, MACC, MERGED};
          pg8::gemm_phase<EpiGate<1>, pg8::StaticOrder, true, true>((PG8_LAS unsigned char*)lds, g, so, e, 1024); }
        { pg8::Gemm g{PROJ + C_Q, (const bf16_t*)(wl + O_WPC), T, 1024, 1024}; EpiGate<2> e{PROJ + C_G + 2048, MACC, MERGED};
          pg8::gemm_phase<EpiGate<2>, pg8::StaticOrder, true, true>((PG8_LAS unsigned char*)lds, g, so, e, INP); }
      }
      if (ph == 6) {
        pg8::Gemm g{MERGED, (const bf16_t*)(wl + O_WO), T, 1024, 1024};
        pg8::StaticOrder so; so.init(T, 1024, nblk, bid);
        EpiF32 e{MIX};
        pg8::gemm_phase<EpiF32, pg8::StaticOrder, true, true>((PG8_LAS unsigned char*)lds, g, so, e);
      }
      if (ph == 7) { TIDX(); phase_resnorm(MIX, xres, p.in[17] + l * 1024, xout, H2, RS2, T, bid * 8 + wid, nblk * 8, lane); }
      if (ph == 8) {
        pg8::Gemm g{H2, (const bf16_t*)(wl + O_WGU), T, 5632, 1024};
        pg8::StaticOrder so; so.init(T, 5632, nblk, bid);
        EpiSwiGLU e{TT, RS2};
        pg8::gemm_phase<EpiSwiGLU, pg8::StaticOrder, true, true>((PG8_LAS unsigned char*)lds, g, so, e);
      }
      if (ph == 9) {
        pg8::Gemm g{TT, (const bf16_t*)(wl + O_WD), T, 1024, DFF};
        pg8::StaticOrder so; so.init(T, 1024, nblk, bid);
        EpiF32 e{FF};
        pg8::gemm_phase<EpiF32, pg8::StaticOrder, true, true>((PG8_LAS unsigned char*)lds, g, so, e);
      }
      if (ph == 10) { TIDX(); phase_resnorm(FF, xout, p.in[22] + l * 1024, xout, l == 0 ? HN : nullptr, l == 0 ? RS1 : nullptr, T, bid * 8 + wid, nblk * 8, lane);
        if (l == 1 && grp < 2) phase_cvt(grp == 0 ? p.in[0] + (size_t)32768 * 1024 : p.in[1], HN, RS1, grp == 0 ? 32768 : 16384, bid * 8 + wid, nblk * 8, lane); }
}

#define GSYNC() xcd_barrier(xb)
__global__ void __launch_bounds__(NTHR) mega(Params p) {
  extern __shared__ __attribute__((aligned(16))) char lds[];
  cg::grid_group grid = cg::this_grid();
  volatile LAS unsigned* bst = (volatile LAS unsigned*)(lds + 151552);
  if (threadIdx.x == 0) { bst[0] = 0u; bst[1] = 0u; }
  __syncthreads();
  const XcdBarrier xb = xcd_barrier_post((unsigned*)(p.ws + O_BAR), bst);
  grid.sync();
  run_phase(p, 0, 0, 0, lds);
  GSYNC();
  for (int grp = 0; grp < 3; ++grp) {
    for (int l = 0; l < 2; ++l)
      for (int ph = 2; ph <= 10; ++ph) { run_phase(p, grp, l, ph, lds); GSYNC(); }
  }
}
__global__ void __launch_bounds__(NTHR) phase_k(Params p, int grp, int l, int ph) {
  extern __shared__ __attribute__((aligned(16))) char lds[];
  run_phase(p, grp, l, ph, lds);
}

extern "C" void kernel_launch(void* const* d_in, const int* in_sizes, int n_in, void* d_out, int out_size, void* d_ws, size_t ws_size, hipStream_t stream) {
  static int grid_blocks = 0;
  if (!grid_blocks) {
    if (ws_size < WS_END) { fprintf(stderr, "kernel_launch: ws too small %zu < %zu\n", ws_size, (size_t)WS_END); return; }
    (void)hipFuncSetAttribute((const void*)mega, hipFuncAttributeMaxDynamicSharedMemorySize, LDS_BYTES);
    (void)hipFuncSetAttribute((const void*)phase_k, hipFuncAttributeMaxDynamicSharedMemorySize, LDS_BYTES);
    int dev = 0, cus = 0, per_cu = 0;
    hipGetDevice(&dev);
    hipDeviceGetAttribute(&cus, hipDeviceAttributeMultiprocessorCount, dev);
    hipOccupancyMaxActiveBlocksPerMultiprocessor(&per_cu, mega, NTHR, LDS_BYTES);
    if (per_cu < 1) per_cu = 1;
    grid_blocks = cus;
    if (grid_blocks > 256) grid_blocks = 256;
  }
  Params p;
  memset(&p, 0, sizeof(p));
  for (int i = 0; i < 23; ++i) p.in[i] = (const float*)d_in[i];
  p.out = (float*)d_out; p.ws = (char*)d_ws;
  (void)hipMemsetAsync((char*)d_ws + O_BAR, 0, 16384, stream);
#ifdef MULTI_LAUNCH
  auto launch = [&](int grp, int l, int ph) { hipLaunchKernelGGL(phase_k, dim3(grid_blocks), dim3(NTHR), LDS_BYTES, stream, p, grp, l, ph); };
  launch(0, 0, 0);
  for (int grp = 0; grp < 3; ++grp) { for (int l = 0; l < 2; ++l) for (int ph = 2; ph <= 10; ++ph) launch(grp, l, ph); }
#else
  void* args[] = {&p};
  hipError_t e = hipLaunchCooperativeKernel((void*)mega, dim3(grid_blocks), dim3(NTHR), args, LDS_BYTES, stream);
  if (e != hipSuccess) fprintf(stderr, "cooperative launch failed: %s (grid %d)\n", hipGetErrorString(e), grid_blocks);
#endif
}
```
